# Optimizing an MI355X kernel written in HIP

```python
import math
import jax, jax.numpy as jnp
from jax import lax
import numpy as np

D_MODEL = 1024
BATCH = 8
SEQ = 4096
DEPTH = 4

EXPAND = 2
D_INNER = EXPAND * D_MODEL
HEAD_DIM = 64
HYENA_WIDTH = D_INNER // 2
ATTN_WIDTH = D_INNER - HYENA_WIDTH
N_HEADS_B = ATTN_WIDTH // HEAD_DIM
N_HEADS_C = D_INNER // HEAD_DIM
HYENA_SHORT = 3
HYENA_EMB_DIM = 33
HYENA_FILTER_ORDER = 64
HYENA_FAST_DECAY = 0.3
HYENA_SLOW_DECAY = 1.5
HYENA_TARGET = 1e-2
DILATED_PATTERNS = ((128, 1), (512, 4), (2048, 16))
QUERY_BLOCK = 64
GRID_W = 64
NA_ROWS_MAX = 8
NA_COLS = 16
REL_BUCKETS = 32
REL_MAX_DIST = 1024
PLE_DIM = 256
N_EVEN = (DEPTH + 1) // 2
N_ODD = DEPTH // 2
RMS_EPS = 1e-6
NEG_INF = -1e30

kernel_name = 'hybrid_hyena_dilated_natten_encoder'


def _rmsnorm(x, g):
    xf = x.astype(jnp.float32)
    y = xf * lax.rsqrt(jnp.mean(xf * xf, axis=-1, keepdims=True) + RMS_EPS)
    return (y * g.astype(jnp.float32)).astype(x.dtype)


def _short_conv(u, w, b):
    up = jnp.pad(u, ((0, 0), (1, 1), (0, 0)))
    return up[:, :-2] * w[0] + up[:, 1:-1] * w[1] + up[:, 2:] * w[2] + b


def _hyena_filters(L, w1, b1, w2, b2, w3, b3, w4, freq):
    f32 = jnp.float32
    t = jnp.linspace(0.0, 1.0, L, dtype=f32)[:, None]
    bands = (HYENA_EMB_DIM - 1) // 2
    fr = jnp.linspace(1e-4, bands - 1, bands, dtype=f32)[None, :]
    wpos = (2.0 * math.pi / L) * jnp.arange(L, dtype=f32)[:, None]
    z = jnp.concatenate([t, jnp.cos(fr * wpos), -jnp.sin(fr * wpos)], axis=-1)
    fq = freq.astype(f32)
    a = jnp.sin(fq * (z @ w1.astype(f32) + b1.astype(f32)))
    a = jnp.sin(fq * (a @ w2.astype(f32) + b2.astype(f32)))
    a = jnp.sin(fq * (a @ w3.astype(f32) + b3.astype(f32)))
    h = (a @ w4.astype(f32)).reshape(L, 2, 2, HYENA_WIDTH)
    min_decay = math.log(HYENA_TARGET) / HYENA_SLOW_DECAY
    max_decay = math.log(HYENA_TARGET) / HYENA_FAST_DECAY
    deltas = jnp.abs(jnp.linspace(min_decay, max_decay, HYENA_WIDTH, dtype=f32))
    h = h * jnp.exp(-t * deltas[None, :])[:, None, None, :]
    fwd = h[:, :, 0]
    bwd = h[1:, :, 1][::-1]
    k = jnp.concatenate([fwd, jnp.zeros((1, 2, HYENA_WIDTH), f32), bwd], axis=0)
    return k / jnp.sum(jnp.abs(k), axis=0, keepdims=True)


def _fft_conv(u, k, skip):
    L = u.shape[1]
    uf = u.astype(jnp.float32)
    spec = jnp.fft.rfft(uf, n=2 * L, axis=1) * jnp.fft.rfft(k, n=2 * L, axis=0)[None]
    y = jnp.fft.irfft(spec, n=2 * L, axis=1)[:, :L]
    return (y + uf * skip.astype(jnp.float32)).astype(u.dtype)


def _hyena(proj, conv_w, conv_b, w1, b1, w2, b2, w3, b3, w4, freq, skip):
    L = proj.shape[1]
    k = _hyena_filters(L, w1, b1, w2, b2, w3, b3, w4, freq)
    v, x1, x2 = jnp.split(_short_conv(proj, conv_w, conv_b), 3, axis=-1)
    z = x1 * _fft_conv(v, k[:, 0], skip[0])
    return x2 * _fft_conv(z, k[:, 1], skip[1])


def _t5_bucket(rel):
    half_b = REL_BUCKETS // 2
    max_exact = half_b // 2
    ret = jnp.where(rel > 0, half_b, 0)
    n = jnp.abs(rel)
    nf = jnp.maximum(n, 1).astype(jnp.float32)
    large = max_exact + (jnp.log(nf / max_exact) / math.log(REL_MAX_DIST / max_exact)
                         * (half_b - max_exact)).astype(jnp.int32)
    large = jnp.minimum(large, half_b - 1)
    return ret + jnp.where(n < max_exact, n, large)


def _dilated_band(q, k, v, window, dil, rel_bias):
    B, H, L, hd = q.shape
    n = L // dil
    half = window // (2 * dil)
    def to_res(a):
        return a.reshape(B, H, n, dil, hd).transpose(0, 1, 3, 2, 4)
    qr, kr, vr = to_res(q), to_res(k), to_res(v)
    qb = math.gcd(n, QUERY_BLOCK)
    nb = n // qb
    kw = qb + 2 * half
    pad = ((0, 0), (0, 0), (0, 0), (half, half), (0, 0))
    kp, vp = jnp.pad(kr, pad), jnp.pad(vr, pad)
    idx = (jnp.arange(nb) * qb)[:, None] + jnp.arange(kw)[None, :]
    kb, vb = kp[:, :, :, idx], vp[:, :, :, idx]
    qblk = qr.reshape(B, H, dil, nb, qb, hd)
    s = jnp.einsum('bhrnqd,bhrnkd->bhrnqk', qblk, kb).astype(jnp.float32) * (hd ** -0.5)
    rel = jnp.arange(kw)[None, :] - half - jnp.arange(qb)[:, None]
    bias = rel_bias[_t5_bucket(rel * dil)].astype(jnp.float32)
    s = s + bias.transpose(2, 0, 1)[None, :, None, None]
    keypos = idx - half
    valid = (jnp.abs(rel) <= half)[None] & ((keypos >= 0) & (keypos < n))[:, None, :]
    s = jnp.where(valid, s, NEG_INF)
    m = jnp.max(s, axis=-1, keepdims=True)
    pe = jnp.exp(s - m)
    den = jnp.sum(pe, axis=-1, keepdims=True)
    o = jnp.einsum('bhrnqk,bhrnkd->bhrnqd', (pe / den).astype(v.dtype), vb)
    lse = (m + jnp.log(den))[..., 0]
    o = o.reshape(B, H, dil, n, hd).transpose(0, 1, 3, 2, 4).reshape(B, H, L, hd)
    lse = lse.reshape(B, H, dil, n).transpose(0, 1, 3, 2).reshape(B, H, L)
    return o, lse


def _dilated_attention(qkv, rel_bias):
    B, L, _ = qkv.shape
    q, k, v = [a.reshape(B, L, N_HEADS_B, HEAD_DIM).transpose(0, 2, 1, 3)
               for a in jnp.split(qkv, 3, axis=-1)]
    outs, lses = [], []
    for window, dil in DILATED_PATTERNS:
        o, lse = _dilated_band(q, k, v, window, dil, rel_bias)
        outs.append(o.astype(jnp.float32))
        lses.append(lse)
    wts = jax.nn.softmax(jnp.stack(lses, axis=0), axis=0)
    o = jnp.einsum('pbhl,pbhld->bhld', wts, jnp.stack(outs, axis=0)).astype(qkv.dtype)
    return o.transpose(0, 2, 1, 3).reshape(B, L, ATTN_WIDTH)


def _neighbourhood_attention(qkv, rpb):
    B, L, _ = qkv.shape
    rows = L // GRID_W
    kr_n = min(NA_ROWS_MAX, rows)
    q, k, v = [a.reshape(B, rows, GRID_W, N_HEADS_C, HEAD_DIM).transpose(0, 3, 1, 2, 4)
               for a in jnp.split(qkv, 3, axis=-1)]
    cols = jnp.arange(GRID_W)
    cs = jnp.clip(cols - NA_COLS // 2, 0, GRID_W - NA_COLS)
    col_idx = cs[:, None] + jnp.arange(NA_COLS)[None, :]
    col_bias_idx = col_idx - cols[:, None] + NA_COLS - 1
    scale = HEAD_DIM ** -0.5
    def row_fn(r):
        rs = jnp.clip(r - kr_n // 2, 0, rows - kr_n)
        qr = lax.dynamic_index_in_dim(q, r, axis=2, keepdims=False)
        kr = lax.dynamic_slice_in_dim(k, rs, kr_n, axis=2)[:, :, :, col_idx]
        vr = lax.dynamic_slice_in_dim(v, rs, kr_n, axis=2)[:, :, :, col_idx]
        s = jnp.einsum('bhqd,bhrqcd->bhqrc', qr, kr).astype(jnp.float32) * scale
        row_bias_idx = rs + jnp.arange(kr_n) - r + NA_ROWS_MAX - 1
        bias = rpb[:, row_bias_idx[None, :, None], col_bias_idx[:, None, :]]
        s = s + bias[None].astype(jnp.float32)
        pr = jax.nn.softmax(s.reshape(B, N_HEADS_C, GRID_W, kr_n * NA_COLS), axis=-1).reshape(s.shape)
        return jnp.einsum('bhqrc,bhrqcd->bhqd', pr.astype(v.dtype), vr)
    o = lax.map(row_fn, jnp.arange(rows))
    return o.transpose(1, 0, 3, 2, 4).reshape(B, L, D_INNER)


def setup_inputs(seed: int = 0) -> dict:
    key = jax.random.key(seed)
    ks = jax.random.split(key, 22)
    f32 = jnp.float32
    def nrm(k, shape, s):
        return jax.random.normal(k, shape, f32) * s
    fo = HYENA_FILTER_ORDER
    return {
        'x': nrm(ks[0], (BATCH, SEQ, D_MODEL), 1.0),
        'p': nrm(ks[1], (DEPTH, BATCH, SEQ, PLE_DIM), 1.0),
        'w_in': nrm(ks[2], (DEPTH, D_MODEL, 4 * D_INNER), D_MODEL ** -0.5),
        'w_out': nrm(ks[3], (DEPTH, D_INNER, D_MODEL), D_INNER ** -0.5),
        'norm_pre': 1.0 + nrm(ks[4], (DEPTH, D_MODEL), 0.02),
        'norm_post': 1.0 + nrm(ks[5], (DEPTH, D_MODEL), 0.02),
        'hyena_conv_w': nrm(ks[6], (N_EVEN, HYENA_SHORT, 3 * HYENA_WIDTH), HYENA_SHORT ** -0.5),
        'hyena_conv_b': nrm(ks[7], (N_EVEN, 3 * HYENA_WIDTH), 0.02),
        'hyena_w1': nrm(ks[8], (N_EVEN, HYENA_EMB_DIM, fo), HYENA_EMB_DIM ** -0.5),
        'hyena_b1': nrm(ks[9], (N_EVEN, fo), 0.02),
        'hyena_w2': nrm(ks[10], (N_EVEN, fo, fo), fo ** -0.5),
        'hyena_b2': nrm(ks[11], (N_EVEN, fo), 0.02),
        'hyena_w3': nrm(ks[12], (N_EVEN, fo, fo), fo ** -0.5),
        'hyena_b3': nrm(ks[13], (N_EVEN, fo), 0.02),
        'hyena_w4': nrm(ks[14], (N_EVEN, fo, 4 * HYENA_WIDTH), fo ** -0.5),
        'hyena_freq': 1.0 + nrm(ks[15], (N_EVEN, fo), 0.02),
        'hyena_skip': nrm(ks[16], (N_EVEN, 2, HYENA_WIDTH), 0.5),
        'rel_bias': nrm(ks[17], (REL_BUCKETS, N_HEADS_B), 0.1),
        'na_rpb': nrm(ks[18], (N_ODD, N_HEADS_C, 2 * NA_ROWS_MAX - 1, 2 * NA_COLS - 1), 0.1),
        'ple_proj': nrm(ks[19], (DEPTH, PLE_DIM, D_MODEL), PLE_DIM ** -0.5),
        'ple_norm': 1.0 + nrm(ks[20], (DEPTH, D_MODEL), 0.02),
        'ple_gate': nrm(ks[21], (DEPTH, D_MODEL, D_MODEL), D_MODEL ** -0.5),
    }


def reference(x, p, w_in, w_out, norm_pre, norm_post, hyena_conv_w, hyena_conv_b,
              hyena_w1, hyena_b1, hyena_w2, hyena_b2, hyena_w3, hyena_b3, hyena_w4,
              hyena_freq, hyena_skip, rel_bias, na_rpb, ple_proj, ple_norm, ple_gate):
    h = x
    for i in range(DEPTH):
        j = i // 2
        u = _rmsnorm(h, norm_pre[i])
        proj = u @ w_in[i]
        if i % 2 == 0:
            a_in, a_gate, b_qkv, b_gate = jnp.split(
                proj, [3 * HYENA_WIDTH, 4 * HYENA_WIDTH, 4 * HYENA_WIDTH + 3 * ATTN_WIDTH], axis=-1)
            ya = _hyena(a_in, hyena_conv_w[j], hyena_conv_b[j], hyena_w1[j], hyena_b1[j],
                        hyena_w2[j], hyena_b2[j], hyena_w3[j], hyena_b3[j], hyena_w4[j],
                        hyena_freq[j], hyena_skip[j]) * jax.nn.silu(a_gate)
            yb = _dilated_attention(b_qkv, rel_bias) * jax.nn.silu(b_gate)
            y = jnp.concatenate([ya, yb], axis=-1)
        else:
            c_qkv, c_gate = jnp.split(proj, [3 * D_INNER], axis=-1)
            y = _neighbourhood_attention(c_qkv, na_rpb[j]) * jax.nn.silu(c_gate)
        h = h + _rmsnorm(y @ w_out[i], norm_post[i])
        e = _rmsnorm(p[i] @ ple_proj[i], ple_norm[i])
        h = h + jax.nn.sigmoid(h @ ple_gate[i]) * e
    return h
```

```cpp
#include <hip/hip_runtime.h>
#include <hip/hip_cooperative_groups.h>
#include <cstdio>
#include <cstdint>
namespace cg = cooperative_groups;

#ifndef REP_MASK
#define REP_MASK 0
#endif
#ifndef HY_FFT
#define HY_FFT 1
#endif
#ifndef ATT_MFMA
#define ATT_MFMA 1
#endif

namespace pg8 {
#define PG8_LAS __attribute__((address_space(3)))
typedef unsigned short bf16_t;
typedef short bf16x8 __attribute__((ext_vector_type(8)));
typedef float f32x4 __attribute__((ext_vector_type(4)));
typedef unsigned u32x4 __attribute__((ext_vector_type(4)));
constexpr int BM = 256, BK = 64, HALF = 128, HTB = HALF * BK * 2, STAGE_BYTES = 8 * HTB, NXCD = 8, WGM = 8;

__host__ __device__ __forceinline__ int lds_byte(int r, int c) { const int st = (r >> 4) * 2 + (c >> 5), rr = r & 15, cc = c & 31, ob = rr * 64 + cc * 2; return st * 1024 + (ob ^ (((ob >> 9) & 1) << 5)); }
__host__ __device__ __forceinline__ void stage_rc(int b, int& R, int& C) { const int st = b / 1024, sb = b % 1024, swz = sb ^ (((sb >> 9) & 1) << 5); R = (st >> 1) * 16 + swz / 64; C = (st & 1) * 32 + (swz % 64) / 2; }
__host__ __device__ __forceinline__ int perm32(int rho) { const int n = rho >> 4, i = rho & 15; return 8 * (i >> 2) + 4 * n + (i & 3); }

struct Unit { int pm, pn; };
struct Gemm { const bf16_t* A; const bf16_t* Bt; int M, N, K, lda, ksplit; long long adj; };

struct StaticOrder {
    int nM, nN, nwg, G, c;
    __host__ __device__ void init(int M, int N, int G_, int c_) { nM = M / BM; nN = N / BM; nwg = nM * nN; G = G_; c = c_; }
    __host__ __device__ bool next(int i, Unit& u) const {
        const long L = (long)i * G + c; if (L >= nwg) return false;
        int wgid = (int)L; { const int q = nwg / NXCD, r = nwg % NXCD, xcd = wgid % NXCD, off = wgid / NXCD; wgid = (xcd < r ? xcd * (q + 1) : r * (q + 1) + (xcd - r) * q) + off; }
        const int nig = WGM * nN, gid = wgid / nig, fm = gid * WGM, gsz = (nM - fm) < WGM ? (nM - fm) : WGM;
        u.pm = fm + ((wgid % nig) % gsz); u.pn = (wgid % nig) / gsz; return true;
    }
};

__device__ __forceinline__ unsigned cvt_pk_bf16(float lo, float hi) { unsigned r; asm volatile("v_cvt_pk_bf16_f32 %0, %1, %2" : "=v"(r) : "v"(lo), "v"(hi)); return r; }

struct EpiF32 {
    static constexpr bool PERM = false;
    float* C; int ldc;
    __device__ __forceinline__ void operator()(const f32x4 (&acc)[2][2][4][2], const Unit& u, int wr, int wc, int fr, int fq) const {
        const int row0 = u.pm * BM + wr * 64 + fr, col0 = u.pn * BM + wc * 32 + 4 * fq;
#pragma unroll
        for (int ai = 0; ai < 2; ++ai)
#pragma unroll
            for (int m = 0; m < 4; ++m) { float* rowp = C + (size_t)(row0 + ai * HALF + m * 16) * ldc + col0;
#pragma unroll
                for (int bj = 0; bj < 2; ++bj)
#pragma unroll
                    for (int n = 0; n < 2; ++n) *(f32x4*)(rowp + bj * HALF + n * 16) = acc[ai][bj][m][n]; }
    }
};
struct EpiBf16 {
    static constexpr bool PERM = true;
    bf16_t* O; size_t ldc; int mode;
    __device__ __forceinline__ size_t rowterm(int row) const { return mode ? ((size_t)(row >> 12) * (16 * 4096 * 64) + (size_t)(row & 4095) * 64) : (size_t)row * ldc; }
    __device__ __forceinline__ size_t colterm(int col) const { return mode ? ((size_t)(col >> 10) * ((size_t)32768 * 1024) + (size_t)((col >> 6) & 15) * (4096 * 64) + (col & 63)) : (size_t)col; }
    __device__ __forceinline__ void operator()(const f32x4 (&acc)[2][2][4][2], const Unit& u, int wr, int wc, int fr, int fq) const {
        const int row0 = u.pm * BM + wr * 64 + fr; const int col0 = u.pn * BM + wc * 32 + 8 * fq;
        const size_t ct0 = colterm(col0), ct1 = colterm(col0 + HALF);
#pragma unroll
        for (int ai = 0; ai < 2; ++ai)
#pragma unroll
            for (int m = 0; m < 4; ++m) { bf16_t* rowp = O + rowterm(row0 + ai * HALF + m * 16);
#pragma unroll
                for (int bj = 0; bj < 2; ++bj) { const f32x4 v0 = acc[ai][bj][m][0], v1 = acc[ai][bj][m][1];
                    u32x4 w; w.x = cvt_pk_bf16(v0[0], v0[1]); w.y = cvt_pk_bf16(v0[2], v0[3]); w.z = cvt_pk_bf16(v1[0], v1[1]); w.w = cvt_pk_bf16(v1[2], v1[3]);
                    *(u32x4*)(rowp + (bj ? ct1 : ct0)) = w; } }
    }
};
struct EpiGate {
    static constexpr bool PERM = true;
    const bf16_t* H1; const bf16_t* E; bf16_t* HB; float* HF; int ldc;
    __device__ __forceinline__ void operator()(const f32x4 (&acc)[2][2][4][2], const Unit& u, int wr, int wc, int fr, int fq) const {
        const int row0 = u.pm * BM + wr * 64 + fr, col0 = u.pn * BM + wc * 32 + 8 * fq;
#pragma unroll
        for (int ai = 0; ai < 2; ++ai) {
            u32x4 hws[4][2], ews[4][2];
#pragma unroll
            for (int m = 0; m < 4; ++m)
#pragma unroll
                for (int bj = 0; bj < 2; ++bj) { const size_t o = (size_t)(row0 + ai * HALF + m * 16) * ldc + col0 + bj * HALF; hws[m][bj] = *(const u32x4*)(H1 + o); ews[m][bj] = *(const u32x4*)(E + o); }
#pragma unroll
            for (int m = 0; m < 4; ++m) { const size_t off = (size_t)(row0 + ai * HALF + m * 16) * ldc + col0;
#pragma unroll
                for (int bj = 0; bj < 2; ++bj) { const size_t o = off + bj * HALF; const u32x4 hw = hws[m][bj]; const u32x4 ew = ews[m][bj];
                    float r[8];
#pragma unroll
                    for (int q = 0; q < 4; ++q) { const float h0 = __uint_as_float(hw[q] << 16), h1 = __uint_as_float(hw[q] & 0xffff0000u), e0 = __uint_as_float(ew[q] << 16), e1 = __uint_as_float(ew[q] & 0xffff0000u);
                        const float g0 = acc[ai][bj][m][q >> 1][(q & 1) * 2], g1 = acc[ai][bj][m][q >> 1][(q & 1) * 2 + 1];
                        r[2 * q] = h0 + e0 * __builtin_amdgcn_rcpf(1.0f + __expf(-g0)); r[2 * q + 1] = h1 + e1 * __builtin_amdgcn_rcpf(1.0f + __expf(-g1)); }
                    if (HF) { *(f32x4*)(HF + o) = (f32x4){r[0], r[1], r[2], r[3]}; *(f32x4*)(HF + o + 4) = (f32x4){r[4], r[5], r[6], r[7]}; }
                    else { u32x4 w; w.x = cvt_pk_bf16(r[0], r[1]); w.y = cvt_pk_bf16(r[2], r[3]); w.z = cvt_pk_bf16(r[4], r[5]); w.w = cvt_pk_bf16(r[6], r[7]); *(u32x4*)(HB + o) = w; } } } }
    }
};

template <class Epi, class Sched, bool ALIGN_EPI = true, bool SP2 = true>
__device__ __forceinline__ void gemm_phase(PG8_LAS unsigned char* lds, const Gemm g, const Sched& S, const Epi& E) {
    int tid_ = threadIdx.x; asm volatile("" : "+v"(tid_));
    const int tid = tid_, wid = __builtin_amdgcn_readfirstlane(tid >> 6), lane = tid & 63, wr = wid >> 2, wc = wid & 3, fr = lane & 15, fq = lane >> 4;
    const int K = g.K, nt = K / BK, lda = g.lda, ksplit = g.ksplit; const long long adj = g.adj;
    unsigned voffA[2], voffB[2];
#pragma unroll
    for (int i = 0; i < 2; ++i) { int R, C; stage_rc(tid * 16 + i * 8192, R, C); const int Rb = Epi::PERM ? ((R & ~31) + perm32(R & 31)) : R;
        voffA[i] = (unsigned)(R * lda + C) * 2u; voffB[i] = (unsigned)(Rb * K + C) * 2u; }
    const size_t kstep = (size_t)(BK * 2);
    const size_t hstepA = (size_t)HALF * lda * 2, hstepB = (size_t)HALF * K * 2;
    const size_t tstepA = 2 * hstepA, tstepB = 2 * hstepB;
    const unsigned ldsw = (unsigned)wid * 1024u;
    const int aoff = lds_byte(wr * 64 + fr, fq * 8), boff = lds_byte(wc * 32 + fr, fq * 8);
#define PG8_SA(b, h) (((b) * 2 + (h)) * HTB)
#define PG8_SB(b, h) ((4 + (b) * 2 + (h)) * HTB)
#define PG8_STAGE(bufoff, gbase, voff) do { _Pragma("unroll") for (int _i = 0; _i < 2; ++_i) \
        __builtin_amdgcn_global_load_lds((const unsigned*)((const char*)(gbase) + (voff)[_i]), (PG8_LAS unsigned*)(lds + (bufoff) + ldsw + _i * 8192), 16, 0, 0); } while (0)
#define PG8_LDA(dst, b, h) do { _Pragma("unroll") for (int m = 0; m < 4; ++m) _Pragma("unroll") for (int k = 0; k < 2; ++k) dst[m][k] = *(const PG8_LAS bf16x8*)(lds + PG8_SA(b, h) + aoff + m * 2048 + k * 1024); } while (0)
#define PG8_LDB(dst, b, h) do { _Pragma("unroll") for (int n = 0; n < 2; ++n) _Pragma("unroll") for (int k = 0; k < 2; ++k) dst[n][k] = *(const PG8_LAS bf16x8*)(lds + PG8_SB(b, h) + boff + n * 2048 + k * 1024); } while (0)
#define PG8_MMA(ai, bj, At, Bt) do { __builtin_amdgcn_s_setprio(1); _Pragma("unroll") for (int m = 0; m < 4; ++m) _Pragma("unroll") for (int n = 0; n < 2; ++n) _Pragma("unroll") for (int k = 0; k < 2; ++k) \
        acc[ai][bj][m][n] = __builtin_amdgcn_mfma_f32_16x16x32_bf16(Bt[n][k], At[m][k], acc[ai][bj][m][n], 0, 0, 0); __builtin_amdgcn_s_setprio(0); } while (0)
#define PG8_WAIT_V(n) asm volatile("s_waitcnt vmcnt(" #n ")" ::: "memory")
#define PG8_WAIT_L(n) asm volatile("s_waitcnt lgkmcnt(" #n ")" ::: "memory")
#define PG8_BAR __builtin_amdgcn_s_barrier()
#define PG8_SCHED __builtin_amdgcn_sched_barrier(0)
#define PG8_ATILE(base, tt) ((base) + (size_t)(tt) * kstep + (((tt) >= ksplit) ? adj : 0ll))
    Unit cur, nxt; int ui = 0;
    if (!S.next(0, cur)) return;
    f32x4 acc[2][2][4][2];
#pragma unroll
    for (int a = 0; a < 2; ++a)
#pragma unroll
        for (int b = 0; b < 2; ++b)
#pragma unroll
            for (int m = 0; m < 4; ++m)
#pragma unroll
                for (int n = 0; n < 2; ++n) acc[a][b][m][n] = (f32x4){0.f, 0.f, 0.f, 0.f};
    bf16x8 At[4][2], B0[2][2], B1[2][2];
    const char* cA = (const char*)g.A + (size_t)cur.pm * tstepA; const char* cB = (const char*)g.Bt + (size_t)cur.pn * tstepB;
    if constexpr (SP2) {
        PG8_STAGE(PG8_SB(0, 0), cB, voffB); PG8_STAGE(PG8_SB(0, 1), cB + hstepB, voffB); PG8_STAGE(PG8_SA(0, 0), cA, voffA); PG8_STAGE(PG8_SA(0, 1), cA + hstepA, voffA);
        if (wr == 1) PG8_BAR;
        PG8_WAIT_V(2); PG8_BAR;
        PG8_STAGE(PG8_SB(1, 0), cB + kstep, voffB); PG8_STAGE(PG8_SA(1, 0), cA + kstep, voffA); PG8_STAGE(PG8_SB(1, 1), cB + hstepB + kstep, voffB);
        PG8_WAIT_V(6); PG8_BAR;
    } else {
    PG8_STAGE(PG8_SB(0, 0), cB, voffB); PG8_STAGE(PG8_SA(0, 0), cA, voffA); PG8_STAGE(PG8_SB(0, 1), cB + hstepB, voffB); PG8_STAGE(PG8_SA(0, 1), cA + hstepA, voffA);
    if (wr == 1) PG8_BAR;
    PG8_WAIT_V(4); PG8_BAR;
    PG8_STAGE(PG8_SB(1, 0), cB + kstep, voffB); PG8_STAGE(PG8_SA(1, 0), cA + kstep, voffA); PG8_STAGE(PG8_SB(1, 1), cB + hstepB + kstep, voffB);
    PG8_WAIT_V(6); PG8_BAR;
    }
    for (;;) {
        const bool has_next = S.next(ui + 1, nxt);
        const char* nA = has_next ? (const char*)g.A + (size_t)nxt.pm * tstepA : cA; const char* nB = has_next ? (const char*)g.Bt + (size_t)nxt.pn * tstepB : cB;
        for (int t = 0; t < nt; t += 2) {
            const bool last = (t == nt - 2);
            const char* a1 = PG8_ATILE(cA, t + 1);
            const char* a2 = last ? nA : PG8_ATILE(cA, t + 2); const char* b2 = last ? nB : cB + (size_t)(t + 2) * kstep;
            const char* a3 = a2 + kstep; const char* b3 = b2 + kstep;
            if constexpr (SP2) {
            PG8_LDB(B0, 0, 0); PG8_LDB(B1, 0, 1); PG8_SCHED; PG8_LDA(At, 0, 0); PG8_STAGE(PG8_SA(1, 1), a1 + hstepA, voffA);
            PG8_WAIT_V(8); PG8_WAIT_L(0); PG8_BAR; PG8_MMA(0, 0, At, B0); PG8_MMA(0, 1, At, B1); PG8_BAR; PG8_SCHED;
            PG8_LDA(At, 0, 1); PG8_STAGE(PG8_SB(0, 0), b2, voffB); PG8_STAGE(PG8_SB(0, 1), b2 + hstepB, voffB); PG8_STAGE(PG8_SA(0, 0), a2, voffA);
            PG8_WAIT_V(8); PG8_WAIT_L(0); PG8_BAR; PG8_MMA(1, 0, At, B0); PG8_MMA(1, 1, At, B1); PG8_BAR; PG8_SCHED;
            PG8_LDB(B0, 1, 0); PG8_LDB(B1, 1, 1); PG8_SCHED; PG8_LDA(At, 1, 0); PG8_STAGE(PG8_SA(0, 1), a2 + hstepA, voffA);
            PG8_WAIT_V(8); PG8_WAIT_L(0); PG8_BAR; PG8_MMA(0, 0, At, B0); PG8_MMA(0, 1, At, B1); PG8_BAR; PG8_SCHED;
            PG8_LDA(At, 1, 1); PG8_STAGE(PG8_SB(1, 0), b3, voffB); PG8_STAGE(PG8_SB(1, 1), b3 + hstepB, voffB); PG8_STAGE(PG8_SA(1, 0), a3, voffA);
            PG8_WAIT_V(8); PG8_WAIT_L(0); PG8_BAR; PG8_MMA(1, 0, At, B0); PG8_MMA(1, 1, At, B1); PG8_BAR; PG8_SCHED;
            } else {
            PG8_LDB(B0, 0, 0); PG8_SCHED; PG8_LDA(At, 0, 0); PG8_STAGE(PG8_SA(1, 1), a1 + hstepA, voffA);
            PG8_WAIT_L(8); PG8_BAR; PG8_WAIT_L(0); PG8_MMA(0, 0, At, B0); PG8_BAR; PG8_SCHED;
            PG8_LDB(B1, 0, 1); PG8_STAGE(PG8_SB(0, 0), b2, voffB);
            PG8_BAR; PG8_WAIT_L(0); PG8_MMA(0, 1, At, B1); PG8_BAR;
            PG8_LDA(At, 0, 1); PG8_STAGE(PG8_SA(0, 0), a2, voffA);
            PG8_BAR; PG8_WAIT_L(0); PG8_MMA(1, 0, At, B0); PG8_BAR; PG8_SCHED;
            PG8_STAGE(PG8_SB(0, 1), b2 + hstepB, voffB);
            PG8_WAIT_V(6); PG8_BAR; PG8_MMA(1, 1, At, B1); PG8_BAR;
            PG8_LDB(B0, 1, 0); PG8_SCHED; PG8_LDA(At, 1, 0); PG8_STAGE(PG8_SA(0, 1), a2 + hstepA, voffA);
            PG8_WAIT_L(8); PG8_BAR; PG8_WAIT_L(0); PG8_MMA(0, 0, At, B0); PG8_BAR; PG8_SCHED;
            PG8_LDB(B1, 1, 1); PG8_STAGE(PG8_SB(1, 0), b3, voffB);
            PG8_BAR; PG8_WAIT_L(0); PG8_MMA(0, 1, At, B1); PG8_BAR;
            PG8_LDA(At, 1, 1); PG8_STAGE(PG8_SA(1, 0), a3, voffA);
            PG8_BAR; PG8_WAIT_L(0); PG8_MMA(1, 0, At, B0); PG8_BAR; PG8_SCHED;
            PG8_STAGE(PG8_SB(1, 1), b3 + hstepB, voffB);
            PG8_WAIT_V(6); PG8_BAR; PG8_MMA(1, 1, At, B1); PG8_BAR;
            }
        }
        if constexpr (ALIGN_EPI) { if (wr == 0) PG8_BAR; }
        E(acc, cur, wr, wc, fr, fq);
        if (!has_next) break;
#pragma unroll
        for (int a = 0; a < 2; ++a)
#pragma unroll
            for (int b = 0; b < 2; ++b)
#pragma unroll
                for (int m = 0; m < 4; ++m)
#pragma unroll
                    for (int n = 0; n < 2; ++n) acc[a][b][m][n] = (f32x4){0.f, 0.f, 0.f, 0.f};
        cur = nxt; cA = nA; cB = nB; ++ui;
        if constexpr (ALIGN_EPI) { if (wr == 1) PG8_BAR; }
    }
    PG8_WAIT_V(0);
    if constexpr (!ALIGN_EPI) { if (wr == 0) PG8_BAR; }
    PG8_BAR;
#undef PG8_SA
#undef PG8_SB
#undef PG8_STAGE
#undef PG8_LDA
#undef PG8_LDB
#undef PG8_MMA
#undef PG8_WAIT_V
#undef PG8_WAIT_L
#undef PG8_BAR
#undef PG8_SCHED
#undef PG8_ATILE
}
}

typedef unsigned short bf16_t;
#define LAS __attribute__((address_space(3)))
constexpr int NT = 512;
constexpr int T_TOK = 32768, SEQ = 4096, NB = 8, DM = 1024, PLE = 256;
constexpr size_t MiB = (size_t)1 << 20;
constexpr size_t WS_U = 0, WS_PROJ = 64 * MiB, WS_T1 = WS_PROJ, WS_E = WS_PROJ + 128 * MiB, WS_YA = 320 * MiB, WS_YB = 384 * MiB,
                 WS_WIN = 448 * MiB, WS_WOUT = 464 * MiB, WS_PPROJ = 468 * MiB, WS_PGATE = 469 * MiB, WS_PB = 472 * MiB, WS_A3 = 488 * MiB, WS_CTL = 490 * MiB, WS_END = 491 * MiB;
constexpr int LDS_BYTES = 144 * 1024 + 16;
constexpr float RMS_EPS = 1e-6f;

struct Params { const float* in[22]; float* out; unsigned char* ws; int ph_lo, ph_hi; };

__device__ __forceinline__ int otid() { int t = threadIdx.x; asm volatile("" : "+v"(t)); return t; }
typedef unsigned ntu4_t __attribute__((ext_vector_type(4)));
typedef float ntf4_t __attribute__((ext_vector_type(4)));
__device__ __forceinline__ uint4 ntld_u4(const void* p) { const ntu4_t v = __builtin_nontemporal_load((const ntu4_t*)p); return make_uint4(v.x, v.y, v.z, v.w); }
__device__ __forceinline__ float4 ntld_f4(const void* p) { const ntf4_t v = __builtin_nontemporal_load((const ntf4_t*)p); return make_float4(v.x, v.y, v.z, v.w); }
__device__ __forceinline__ float bf2f(bf16_t b) { return __uint_as_float(((unsigned)b) << 16); }
__device__ __forceinline__ bf16_t f2bf(float f) { unsigned u = __float_as_uint(f); u += 0x7FFFu + ((u >> 16) & 1u); return (bf16_t)(u >> 16); }
__device__ __forceinline__ int olane() { int l = __builtin_amdgcn_mbcnt_hi(-1, __builtin_amdgcn_mbcnt_lo(-1, 0)); asm volatile("" : "+v"(l)); return l; }
__device__ __forceinline__ float bperm_f(int addr, float v) { return __uint_as_float((unsigned)__builtin_amdgcn_ds_bpermute(addr, (int)__float_as_uint(v))); }
__device__ __forceinline__ float wave_sum(float v) { const int l = olane();
#pragma unroll
    for (int o = 32; o >= 1; o >>= 1) v += bperm_f((l ^ o) << 2, v);
    return v; }
__device__ __forceinline__ float wave_max(float v) { const int l = olane();
#pragma unroll
    for (int o = 32; o >= 1; o >>= 1) v = fmaxf(v, bperm_f((l ^ o) << 2, v));
    return v; }
__device__ __forceinline__ float silu(float x) { return x * __builtin_amdgcn_rcpf(1.0f + __expf(-x)); }

__device__ void ph_rmsnorm_rows(const float* __restrict__ hin, const float* __restrict__ g, bf16_t* __restrict__ out) {
    const int tid = otid(); const int lane = tid & 63, wid = tid >> 6;
    for (int row = blockIdx.x * 8 + wid; row < T_TOK; row += gridDim.x * 8) {
        const float4* src = (const float4*)(hin + (size_t)row * DM);
        float4 v[4]; float ss = 0.f;
#pragma unroll
        for (int i = 0; i < 4; ++i) { v[i] = ntld_f4(src + lane + 64 * i); ss += v[i].x * v[i].x + v[i].y * v[i].y + v[i].z * v[i].z + v[i].w * v[i].w; }
        ss = wave_sum(ss);
        const float r = rsqrtf(ss * (1.0f / DM) + RMS_EPS);
#pragma unroll
        for (int i = 0; i < 4; ++i) { const float4 gv = ((const float4*)g)[lane + 64 * i];
            uint2 w; w.x = pg8::cvt_pk_bf16(v[i].x * r * gv.x, v[i].y * r * gv.y); w.y = pg8::cvt_pk_bf16(v[i].z * r * gv.z, v[i].w * r * gv.w);
            *(uint2*)(out + (size_t)row * DM + (lane + 64 * i) * 4) = w; }
    }
}
__device__ void ph_rmsnorm_rows_b16(const bf16_t* __restrict__ hb, const float* __restrict__ g, bf16_t* __restrict__ out) {
    const int tid = otid(); const int lane = tid & 63, wid = tid >> 6;
    for (int row = blockIdx.x * 8 + wid; row < T_TOK; row += gridDim.x * 8) {
        const size_t ro = (size_t)row * DM; uint4 w[2]; float v[2][8]; float ss = 0.f;
#pragma unroll
        for (int i = 0; i < 2; ++i) w[i] = ntld_u4(hb + ro + (lane + 64 * i) * 8);
#pragma unroll
        for (int i = 0; i < 2; ++i) { const unsigned ww[4] = {w[i].x, w[i].y, w[i].z, w[i].w};
#pragma unroll
            for (int k = 0; k < 4; ++k) { v[i][2 * k] = __uint_as_float(ww[k] << 16); v[i][2 * k + 1] = __uint_as_float(ww[k] & 0xffff0000u); ss += v[i][2 * k] * v[i][2 * k] + v[i][2 * k + 1] * v[i][2 * k + 1]; } }
        ss = wave_sum(ss);
        const float r = rsqrtf(ss * (1.0f / DM) + RMS_EPS);
        float4 gaa[2], gbb[2];
#pragma unroll
        for (int i = 0; i < 2; ++i) { const int e0 = (lane + 64 * i) * 8; gaa[i] = *(const float4*)(g + e0); gbb[i] = *(const float4*)(g + e0 + 4); }
#pragma unroll
        for (int i = 0; i < 2; ++i) { const int e0 = (lane + 64 * i) * 8; const float4 ga = gaa[i], gb = gbb[i];
            uint4 o; o.x = pg8::cvt_pk_bf16(v[i][0] * r * ga.x, v[i][1] * r * ga.y); o.y = pg8::cvt_pk_bf16(v[i][2] * r * ga.z, v[i][3] * r * ga.w);
            o.z = pg8::cvt_pk_bf16(v[i][4] * r * gb.x, v[i][5] * r * gb.y); o.w = pg8::cvt_pk_bf16(v[i][6] * r * gb.z, v[i][7] * r * gb.w);
            *(uint4*)(out + ro + e0) = o; }
    }
}
__device__ void prep_tile(const float* __restrict__ src, int srcld, bf16_t* __restrict__ dst, int K, int n0, int srccol0, int k0, float* sl) {
    const int tid = otid();
#pragma unroll
    for (int i = 0; i < 2; ++i) { const int idx = tid + NT * i, kk = idx >> 4, c4 = idx & 15;
        const float4 v = ntld_f4(src + (size_t)(k0 + kk) * srcld + srccol0 + c4 * 4);
        float* d = sl + kk * 65 + c4 * 4; d[0] = v.x; d[1] = v.y; d[2] = v.z; d[3] = v.w; }
    __syncthreads();
    { const int n = tid >> 3, kg = tid & 7; float f[8];
#pragma unroll
      for (int j = 0; j < 8; ++j) f[j] = sl[(kg * 8 + j) * 65 + n];
      uint4 w; w.x = pg8::cvt_pk_bf16(f[0], f[1]); w.y = pg8::cvt_pk_bf16(f[2], f[3]); w.z = pg8::cvt_pk_bf16(f[4], f[5]); w.w = pg8::cvt_pk_bf16(f[6], f[7]);
      *(uint4*)(dst + (size_t)(n0 + n) * K + k0 + kg * 8) = w; }
    __syncthreads();
}
__device__ void ph_prep_weights(const Params& P, int layer, float* sl) {
    unsigned char* ws = P.ws;
    const bool odd = (layer & 1);
    for (int t = blockIdx.x; t < 2880; t += gridDim.x) {
        if (t < 2048) { const int nt_ = t >> 4, kt = t & 15, n0 = nt_ * 64; int sc = n0;
            if (odd) { const int half = n0 >> 12, j = n0 & 4095; sc = (j >> 10) * 2048 + half * 1024 + (j & 1023); }
            prep_tile(P.in[2] + (size_t)layer * 1024 * 8192, 8192, (bf16_t*)(ws + WS_WIN), 1024, n0, sc, kt * 64, sl); }
        else if (t < 2560) { const int q = t - 2048, nt_ = q >> 5, kt = q & 31;
            prep_tile(P.in[3] + (size_t)layer * 2048 * 1024, 1024, (bf16_t*)(ws + WS_WOUT), 2048, nt_ * 64, nt_ * 64, kt * 64, sl); }
        else if (t < 2624) { const int q = t - 2560, nt_ = q >> 2, kt = q & 3;
            prep_tile(P.in[19] + (size_t)layer * 256 * 1024, 1024, (bf16_t*)(ws + WS_PPROJ), 256, nt_ * 64, nt_ * 64, kt * 64, sl); }
        else { const int q = t - 2624, nt_ = q >> 4, kt = q & 15;
            prep_tile(P.in[21] + (size_t)layer * 1024 * 1024, 1024, (bf16_t*)(ws + WS_PGATE), 1024, nt_ * 64, nt_ * 64, kt * 64, sl); }
    }
}
__device__ void ph_convert_p(const float* __restrict__ p, bf16_t* __restrict__ pb) {
    const size_t n4 = (size_t)T_TOK * PLE / 4;
    for (size_t i = (size_t)blockIdx.x * NT + otid(); i < n4; i += (size_t)gridDim.x * NT) {
        const float4 v = ntld_f4(((const float4*)p) + i); uint2 w; w.x = pg8::cvt_pk_bf16(v.x, v.y); w.y = pg8::cvt_pk_bf16(v.z, v.w); ((uint2*)pb)[i] = w; }
}
__device__ void ph_filter_mlp(const Params& P, int j, float* __restrict__ a3) {
    const int tid = otid(); const int lane = tid & 63, wid = tid >> 6;
    const float* w1 = P.in[8] + (size_t)j * 33 * 64; const float* b1 = P.in[9] + j * 64;
    const float* w2 = P.in[10] + (size_t)j * 64 * 64; const float* b2 = P.in[11] + j * 64;
    const float* w3 = P.in[12] + (size_t)j * 64 * 64; const float* b3 = P.in[13] + j * 64;
    const float fq = P.in[15][j * 64 + lane];
    for (int pos = blockIdx.x * 8 + wid; pos < SEQ; pos += gridDim.x * 8) {
        float z = 0.f;
        const float wpos = (float)(2.0 * 3.14159265358979323846 / SEQ) * (float)pos;
        if (lane == 0) z = (float)pos / (float)(SEQ - 1);
        else if (lane <= 16) { const float fr = 1e-4f + (float)(lane - 1) * ((15.0f - 1e-4f) / 15.0f); z = cosf(fr * wpos); }
        else if (lane <= 32) { const float fr = 1e-4f + (float)(lane - 17) * ((15.0f - 1e-4f) / 15.0f); z = -sinf(fr * wpos); }
        float acc = b1[lane];
        for (int i = 0; i < 33; ++i) acc += __shfl(z, i) * w1[i * 64 + lane];
        float a = sinf(fq * acc);
        acc = b2[lane];
        for (int i = 0; i < 64; ++i) acc += __shfl(a, i) * w2[i * 64 + lane];
        a = sinf(fq * acc);
        acc = b3[lane];
        for (int i = 0; i < 64; ++i) acc += __shfl(a, i) * w3[i * 64 + lane];
        a = sinf(fq * acc);
        a3[pos * 64 + lane] = a;
    }
}
__device__ void ph_filter_gen(const Params& P, int j, const float* __restrict__ a3, float* __restrict__ kf, float* sl) {
    const int tid = otid(), lane = tid & 63, wid = tid >> 6;
    const float* w4 = P.in[14] + (size_t)j * 64 * 4096;
    float* sw = sl; float* red = sl + 256;
    const float min_decay = logf(1e-2f) / 1.5f, max_decay = logf(1e-2f) / 0.3f;
    for (int c = blockIdx.x; c < 1024; c += gridDim.x) {
        if (tid < 256) { const int jj = tid >> 2, q = tid & 3; sw[tid] = w4[(size_t)jj * 4096 + q * 1024 + c]; }
        __syncthreads();
        const float delta = fabsf(min_decay + (float)c * ((max_decay - min_decay) / 1023.0f));
        float hv[8][4]; float n0 = 0.f, n1 = 0.f;
#pragma unroll
        for (int i = 0; i < 8; ++i) { const int t = tid + NT * i; const float4* ar = (const float4*)(a3 + (size_t)t * 64);
            float a0 = 0.f, a1 = 0.f, a2 = 0.f, a3v = 0.f;
#pragma unroll 4
            for (int jq = 0; jq < 16; ++jq) { const float4 av = ar[jq]; const float ae[4] = {av.x, av.y, av.z, av.w};
#pragma unroll
                for (int e = 0; e < 4; ++e) { const float4 wv = *(const float4*)(sw + (jq * 4 + e) * 4); a0 += ae[e] * wv.x; a1 += ae[e] * wv.y; a2 += ae[e] * wv.z; a3v += ae[e] * wv.w; } }
            const float dec = expf(-((float)t / (float)(SEQ - 1)) * delta);
            hv[i][0] = a0 * dec; hv[i][1] = a1 * dec; hv[i][2] = a2 * dec; hv[i][3] = a3v * dec;
            n0 += fabsf(hv[i][0]) + (t >= 1 ? fabsf(hv[i][1]) : 0.f); n1 += fabsf(hv[i][2]) + (t >= 1 ? fabsf(hv[i][3]) : 0.f); }
        n0 = wave_sum(n0); n1 = wave_sum(n1);
        if (lane == 0) { red[wid * 2] = n0; red[wid * 2 + 1] = n1; }
        __syncthreads();
        float s0 = 0.f, s1 = 0.f;
#pragma unroll
        for (int w = 0; w < 8; ++w) { s0 += red[w * 2]; s1 += red[w * 2 + 1]; }
        const float i0 = 1.0f / s0, i1 = 1.0f / s1;
        float* k0 = kf + (size_t)c * 8192; float* k1 = kf + (size_t)(1024 + c) * 8192;
#pragma unroll
        for (int i = 0; i < 8; ++i) { const int t = tid + NT * i;
            k0[t] = hv[i][0] * i0; k1[t] = hv[i][2] * i1;
            if (t >= 1) { k0[8192 - t] = hv[i][1] * i0; k1[8192 - t] = hv[i][3] * i1; } }
        if (tid == 0) { k0[4096] = 0.f; k1[4096] = 0.f; }
        __syncthreads();
    }
}

__device__ __forceinline__ float sconv(const bf16_t* row, int t, float w0, float w1, float w2, float b) {
    const float xm = t > 0 ? bf2f(row[t - 1]) : 0.f, x0 = bf2f(row[t]), xp = t < SEQ - 1 ? bf2f(row[t + 1]) : 0.f;
    return w0 * xm + w1 * x0 + w2 * xp + b; }
__device__ void ph_hyena_naive(const Params& P, int j, const bf16_t* __restrict__ projAT, const float* __restrict__ kf, bf16_t* __restrict__ yaT, float* sl) {
    const int tid = otid();
    float* sv = sl; float* sk = sl + 4096; float* sz = sk + 8192;
    const float* cw = P.in[6] + (size_t)j * 3 * 3072; const float* cb = P.in[7] + (size_t)j * 3072; const float* skip = P.in[16] + (size_t)j * 2 * 1024;
    for (int unit = blockIdx.x; unit < 8192; unit += gridDim.x) {
        const int c = unit >> 3, b = unit & 7;
        const bf16_t* vrow = projAT + (size_t)c * T_TOK + b * SEQ; const bf16_t* x1row = projAT + (size_t)(1024 + c) * T_TOK + b * SEQ;
        const bf16_t* x2row = projAT + (size_t)(2048 + c) * T_TOK + b * SEQ; const bf16_t* grow = projAT + (size_t)(3072 + c) * T_TOK + b * SEQ;
        const float wv0 = cw[c], wv1 = cw[3072 + c], wv2 = cw[6144 + c], bv = cb[c];
        const float wa0 = cw[1024 + c], wa1 = cw[3072 + 1024 + c], wa2 = cw[6144 + 1024 + c], ba = cb[1024 + c];
        const float wb0 = cw[2048 + c], wb1 = cw[3072 + 2048 + c], wb2 = cw[6144 + 2048 + c], bb = cb[2048 + c];
        const float sk0 = skip[c], sk1 = skip[1024 + c];
        for (int t = tid; t < SEQ; t += NT) sv[t] = sconv(vrow, t, wv0, wv1, wv2, bv);
        for (int i = tid; i < 8192; i += NT) sk[i] = kf[(size_t)c * 8192 + i];
        __syncthreads();
        float acc[8];
#pragma unroll
        for (int i = 0; i < 8; ++i) acc[i] = 0.f;
        for (int s = 0; s < SEQ; ++s) { const float vs = sv[s];
#pragma unroll
            for (int i = 0; i < 8; ++i) acc[i] += vs * sk[(tid + NT * i - s) & 8191]; }
#pragma unroll
        for (int i = 0; i < 8; ++i) { const int t = tid + NT * i; sz[t] = sconv(x1row, t, wa0, wa1, wa2, ba) * (acc[i] + sk0 * sv[t]); }
        __syncthreads();
        for (int i = tid; i < 8192; i += NT) sk[i] = kf[(size_t)(1024 + c) * 8192 + i];
        __syncthreads();
#pragma unroll
        for (int i = 0; i < 8; ++i) acc[i] = 0.f;
        for (int s = 0; s < SEQ; ++s) { const float vs = sz[s];
#pragma unroll
            for (int i = 0; i < 8; ++i) acc[i] += vs * sk[(tid + NT * i - s) & 8191]; }
#pragma unroll
        for (int i = 0; i < 8; ++i) { const int t = tid + NT * i;
            const float y = sconv(x2row, t, wb0, wb1, wb2, bb) * (acc[i] + sk1 * sz[t]) * silu(bf2f(grow[t]));
            yaT[(size_t)c * T_TOK + b * SEQ + t] = f2bf(y); }
        __syncthreads();
    }
}

struct cf { float x, y; };
__device__ __forceinline__ cf cmul(cf a, cf b) { return cf{a.x * b.x - a.y * b.y, a.x * b.y + a.y * b.x}; }
__device__ __forceinline__ cf cmulc(cf a, cf b) { return cf{a.x * b.x + a.y * b.y, a.y * b.x - a.x * b.y}; }
__device__ __forceinline__ constexpr float c16(int k) { constexpr float t[8] = {1.0f, 0.92387953251128674f, 0.70710678118654752f, 0.38268343236508977f, 0.0f, -0.38268343236508977f, -0.70710678118654752f, -0.92387953251128674f}; return t[k]; }
__device__ __forceinline__ constexpr float s16(int k) { constexpr float t[8] = {0.0f, 0.38268343236508977f, 0.70710678118654752f, 0.92387953251128674f, 1.0f, 0.92387953251128674f, 0.70710678118654752f, 0.38268343236508977f}; return t[k]; }
__device__ __forceinline__ cf twc(cf ws, int k16) { if (k16 == 0) return ws; if (k16 == 4) return cf{ws.y, -ws.x}; return cmul(ws, cf{c16(k16), -s16(k16)}); }
template <int LR> __device__ __forceinline__ void dif_reg(cf (&x)[1 << LR], cf w) {
    constexpr int R = 1 << LR; cf ws = w;
#pragma unroll
    for (int s = 0; s < LR; ++s) { const int half = R >> (s + 1);
#pragma unroll
        for (int m0 = 0; m0 < R; m0 += 2 * half)
#pragma unroll
            for (int mm = 0; mm < half; ++mm) { const int ia = m0 + mm, ib = ia + half; const cf a = x[ia], b = x[ib];
                x[ia] = cf{a.x + b.x, a.y + b.y}; const cf d{a.x - b.x, a.y - b.y};
                x[ib] = cmul(d, twc(ws, (mm << s) * (16 / R))); }
        ws = cmul(ws, ws); }
}
template <int LR> __device__ __forceinline__ void dit_reg(cf (&x)[1 << LR], cf w) {
    constexpr int R = 1 << LR; cf wsv[LR]; wsv[0] = w;
#pragma unroll
    for (int s = 1; s < LR; ++s) wsv[s] = cmul(wsv[s - 1], wsv[s - 1]);
#pragma unroll
    for (int s = LR - 1; s >= 0; --s) { const int half = R >> (s + 1);
#pragma unroll
        for (int m0 = 0; m0 < R; m0 += 2 * half)
#pragma unroll
            for (int mm = 0; mm < half; ++mm) { const int ia = m0 + mm, ib = ia + half; const cf a = x[ia];
                const cf b = cmulc(x[ib], twc(wsv[s], (mm << s) * (16 / R)));
                x[ia] = cf{a.x + b.x, a.y + b.y}; x[ib] = cf{a.x - b.x, a.y - b.y}; } }
}
typedef float v2f __attribute__((ext_vector_type(2)));
__device__ __forceinline__ v2f mkv2(float a, float b) { v2f r; r.x = a; r.y = b; return r; }
typedef LAS v2f* ldsf2;
__device__ __forceinline__ void lds_barrier() { asm volatile("s_waitcnt lgkmcnt(0)\n\ts_barrier" ::: "memory"); }
template <int LR, bool INV> __device__ __forceinline__ void fft_pass(ldsf2 buf, int base, int stride, int twi) {
    constexpr int R = 1 << LR; cf x[R];
    const v2f wv = ((ldsf2)((LAS unsigned char*)buf + 139264))[twi];
#pragma unroll
    for (int m = 0; m < R; ++m) { const v2f v = buf[base + m * stride]; x[m] = cf{v.x, v.y}; }
    const cf w{wv.x, wv.y};
    if (INV) dit_reg<LR>(x, w); else dif_reg<LR>(x, w);
#pragma unroll
    for (int m = 0; m < R; ++m) buf[base + m * stride] = mkv2(x[m].x, x[m].y);
}
__device__ __forceinline__ void wave_lds_fence() { asm volatile("s_waitcnt lgkmcnt(0)" ::: "memory"); }
__device__ __forceinline__ void fft_fwd_abc(ldsf2 buf) {
    const int tid = otid(); const int wv = tid >> 6, l = tid & 63;
#pragma unroll 1
    for (int u = 0; u < 2; ++u) { const int bf = tid + NT * u; fft_pass<3, false>(buf, bf + (bf >> 4), 1088, bf); }
    lds_barrier();
#pragma unroll 1
    for (int u = 0; u < 2; ++u) { const int o = l + 64 * u, e0 = wv * 1024 + o; fft_pass<3, false>(buf, e0 + (e0 >> 4), 136, o * 8); }
    wave_lds_fence();
#pragma unroll 1
    for (int u = 0; u < 2; ++u) { const int j = l + 64 * u, o = j & 15, e0 = wv * 1024 + (j >> 4) * 128 + o; fft_pass<3, false>(buf, e0 + (e0 >> 4), 17, o * 64); }
    wave_lds_fence();
}
__device__ __forceinline__ void fft_inv_cba(ldsf2 buf) {
    const int tid = otid(); const int wv = tid >> 6, l = tid & 63;
#pragma unroll 1
    for (int u = 0; u < 2; ++u) { const int j = l + 64 * u, o = j & 15, e0 = wv * 1024 + (j >> 4) * 128 + o; fft_pass<3, true>(buf, e0 + (e0 >> 4), 17, o * 64); }
    wave_lds_fence();
#pragma unroll 1
    for (int u = 0; u < 2; ++u) { const int o = l + 64 * u, e0 = wv * 1024 + o; fft_pass<3, true>(buf, e0 + (e0 >> 4), 136, o * 8); }
    lds_barrier();
#pragma unroll 1
    for (int u = 0; u < 2; ++u) { const int bf = tid + NT * u; fft_pass<3, true>(buf, bf + (bf >> 4), 1088, bf); }
    lds_barrier();
}
typedef _Float16 h2_t __attribute__((ext_vector_type(2)));
__device__ __forceinline__ void make_spec(ldsf2 buf, LAS unsigned* spec, const float* __restrict__ kfrow) {
    const int tid = otid();
#pragma unroll
    for (int q = 0; q < 4; ++q) { const float4 v = *(const float4*)(kfrow + tid * 16 + q * 4);
        buf[tid * 17 + q * 4 + 0] = mkv2(v.x, 0.f); buf[tid * 17 + q * 4 + 1] = mkv2(v.y, 0.f); buf[tid * 17 + q * 4 + 2] = mkv2(v.z, 0.f); buf[tid * 17 + q * 4 + 3] = mkv2(v.w, 0.f); }
    __syncthreads();
    fft_fwd_abc(buf);
    cf x[16];
#pragma unroll
    for (int m = 0; m < 16; ++m) { const v2f v = buf[tid * 17 + m]; x[m] = cf{v.x, v.y}; }
    dif_reg<4>(x, cf{1.0f, 0.0f});
#pragma unroll
    for (int m = 0; m < 16; ++m) { h2_t hv; hv.x = (_Float16)x[m].x; hv.y = (_Float16)x[m].y; spec[tid * 17 + m] = __builtin_bit_cast(unsigned, hv); }
    lds_barrier();
}
__device__ __forceinline__ void fft_conv(ldsf2 buf, const LAS unsigned* spec) {
    fft_fwd_abc(buf);
    { const int tid = otid(); cf x[16];
#pragma unroll
      for (int m = 0; m < 16; ++m) { const v2f v = buf[tid * 17 + m]; x[m] = cf{v.x, v.y}; }
      dif_reg<4>(x, cf{1.0f, 0.0f});
#pragma unroll
      for (int m = 0; m < 16; ++m) { const h2_t hv = __builtin_bit_cast(h2_t, spec[tid * 17 + m]); x[m] = cmul(x[m], cf{(float)hv.x, (float)hv.y}); }
      dit_reg<4>(x, cf{1.0f, 0.0f});
#pragma unroll
      for (int m = 0; m < 16; ++m) buf[tid * 17 + m] = mkv2(x[m].x, x[m].y); }
    wave_lds_fence();
    fft_inv_cba(buf);
}
struct Raw8 { uint4 body; unsigned short eL, eR; };
__device__ __forceinline__ Raw8 load_raw8(const bf16_t* __restrict__ row, int n0) {
    Raw8 r; r.body = ntld_u4(row + n0); r.eL = row[n0 > 0 ? n0 - 1 : 0]; r.eR = row[n0 + 8 < SEQ ? n0 + 8 : SEQ - 1]; return r; }
__device__ __forceinline__ void sconv8(const Raw8& r, int n0, float w0, float w1, float w2, float b, float (&out)[8]) {
    float a[10]; a[0] = n0 > 0 ? bf2f(r.eL) : 0.f; a[9] = n0 + 8 < SEQ ? bf2f(r.eR) : 0.f;
    a[1] = __uint_as_float(r.body.x << 16); a[2] = __uint_as_float(r.body.x & 0xffff0000u); a[3] = __uint_as_float(r.body.y << 16); a[4] = __uint_as_float(r.body.y & 0xffff0000u);
    a[5] = __uint_as_float(r.body.z << 16); a[6] = __uint_as_float(r.body.z & 0xffff0000u); a[7] = __uint_as_float(r.body.w << 16); a[8] = __uint_as_float(r.body.w & 0xffff0000u);
#pragma unroll
    for (int k = 0; k < 8; ++k) out[k] = w0 * a[k] + w1 * a[k + 1] + w2 * a[k + 2] + b;
}
__device__ void ph_hyena_fft(const Params& P, int j, const bf16_t* __restrict__ projAT, const float* __restrict__ kf, bf16_t* __restrict__ yaT, unsigned char* lds_raw) {
    const int tid = otid();
    ldsf2 buf = (ldsf2)lds_raw; LAS unsigned* spec1 = (LAS unsigned*)(lds_raw + 69632); LAS unsigned* spec2 = spec1 + 8704;
    const float* cw = P.in[6] + (size_t)j * 3 * 3072; const float* cb = P.in[7] + (size_t)j * 3072; const float* skip = P.in[16] + (size_t)j * 2 * 1024;
    const float invN = 1.0f / 8192.0f;
    const int n0 = tid * 8, ph0 = n0 + (n0 >> 4);
    { ldsf2 twt = (ldsf2)((LAS unsigned char*)buf + 139264);
      for (int k = tid; k < 1024; k += NT) { float sn, cs; sincospif((float)k * (2.0f / 8192.0f), &sn, &cs); twt[k] = mkv2(cs, -sn); }
      __syncthreads(); }
#pragma unroll 1
    for (int c = blockIdx.x; c < 1024; c += gridDim.x) {
        make_spec(buf, spec1, kf + (size_t)c * 8192);
        make_spec(buf, spec2, kf + (size_t)(1024 + c) * 8192);
        const float wv0 = cw[c], wv1 = cw[3072 + c], wv2 = cw[6144 + c], bv = cb[c];
        const float wa0 = cw[1024 + c], wa1 = cw[3072 + 1024 + c], wa2 = cw[6144 + 1024 + c], ba = cb[1024 + c];
        const float wb0 = cw[2048 + c], wb1 = cw[3072 + 2048 + c], wb2 = cw[6144 + 2048 + c], bb = cb[2048 + c];
        const float sk0 = skip[c], sk1 = skip[1024 + c];
        const bf16_t* vrow = projAT + (size_t)c * T_TOK; const bf16_t* x1row = projAT + (size_t)(1024 + c) * T_TOK;
        const bf16_t* x2row = projAT + (size_t)(2048 + c) * T_TOK; const bf16_t* grow = projAT + (size_t)(3072 + c) * T_TOK;
#pragma unroll 1
        for (int bp = 0; bp < 4; ++bp) {
            const size_t o0 = (size_t)(2 * bp) * SEQ, o1 = o0 + SEQ;
            float va[8], vb[8];
            { const Raw8 r0 = load_raw8(vrow + o0, n0), r1 = load_raw8(vrow + o1, n0); sconv8(r0, n0, wv0, wv1, wv2, bv, va); sconv8(r1, n0, wv0, wv1, wv2, bv, vb); }
#pragma unroll
            for (int k = 0; k < 8; ++k) { buf[ph0 + k] = mkv2(va[k], vb[k]); buf[ph0 + 4352 + k] = mkv2(0.f, 0.f); }
            const Raw8 xa0 = load_raw8(x1row + o0, n0), xa1 = load_raw8(x1row + o1, n0);
            lds_barrier();
            fft_conv(buf, spec1);
            { float xa[8], xb[8]; sconv8(xa0, n0, wa0, wa1, wa2, ba, xa); sconv8(xa1, n0, wa0, wa1, wa2, ba, xb);
#pragma unroll
              for (int k = 0; k < 8; ++k) { const v2f y = buf[ph0 + k]; va[k] = xa[k] * (y.x * invN + sk0 * va[k]); vb[k] = xb[k] * (y.y * invN + sk0 * vb[k]);
                  buf[ph0 + k] = mkv2(va[k], vb[k]); buf[ph0 + 4352 + k] = mkv2(0.f, 0.f); } }
            const Raw8 xb0 = load_raw8(x2row + o0, n0), xb1 = load_raw8(x2row + o1, n0);
            const uint4 g0 = ntld_u4(grow + o0 + n0), g1 = ntld_u4(grow + o1 + n0);
            lds_barrier();
            fft_conv(buf, spec2);
            { float xa[8], xb[8]; sconv8(xb0, n0, wb0, wb1, wb2, bb, xa); sconv8(xb1, n0, wb0, wb1, wb2, bb, xb);
              const unsigned gw0[4] = {g0.x, g0.y, g0.z, g0.w}, gw1[4] = {g1.x, g1.y, g1.z, g1.w}; unsigned w0[4], w1[4];
#pragma unroll
              for (int k2 = 0; k2 < 4; ++k2) { const v2f ya = buf[ph0 + 2 * k2], yb = buf[ph0 + 2 * k2 + 1];
                  const float ra = xa[2 * k2] * (ya.x * invN + sk1 * va[2 * k2]) * silu(__uint_as_float(gw0[k2] << 16));
                  const float rb = xa[2 * k2 + 1] * (yb.x * invN + sk1 * va[2 * k2 + 1]) * silu(__uint_as_float(gw0[k2] & 0xffff0000u));
                  const float rc = xb[2 * k2] * (ya.y * invN + sk1 * vb[2 * k2]) * silu(__uint_as_float(gw1[k2] << 16));
                  const float rd = xb[2 * k2 + 1] * (yb.y * invN + sk1 * vb[2 * k2 + 1]) * silu(__uint_as_float(gw1[k2] & 0xffff0000u));
                  w0[k2] = (unsigned)f2bf(ra) | ((unsigned)f2bf(rb) << 16); w1[k2] = (unsigned)f2bf(rc) | ((unsigned)f2bf(rd) << 16); }
              *(uint4*)(yaT + (size_t)c * T_TOK + o0 + n0) = make_uint4(w0[0], w0[1], w0[2], w0[3]);
              *(uint4*)(yaT + (size_t)c * T_TOK + o1 + n0) = make_uint4(w1[0], w1[1], w1[2], w1[3]); }
            lds_barrier();
        }
    }
}
__device__ void ph_transpose_ya(const bf16_t* __restrict__ yaT, bf16_t* __restrict__ yA, bf16_t* sl) {
    const int tid = otid();
    const int cc = tid >> 3, t8 = tid & 7;
    int tile = blockIdx.x; if (tile >= 16 * 512) return;
    uint4 v = ntld_u4(yaT + (size_t)((tile & 15) * 64 + cc) * T_TOK + (tile >> 4) * 64 + t8 * 8);
    for (;;) {
        const int c0 = (tile & 15) * 64, t0 = (tile >> 4) * 64;
        { const bf16_t* e = (const bf16_t*)&v;
#pragma unroll
          for (int jx = 0; jx < 8; ++jx) sl[cc * 66 + t8 * 8 + jx] = e[jx]; }
        __syncthreads();
        const int tn = tile + gridDim.x; const bool more = tn < 16 * 512;
        if (more) v = ntld_u4(yaT + (size_t)((tn & 15) * 64 + cc) * T_TOK + (tn >> 4) * 64 + t8 * 8);
        { const int tt = tid >> 3, c8 = tid & 7; unsigned w[4];
#pragma unroll
          for (int jx = 0; jx < 4; ++jx) w[jx] = (unsigned)sl[(c8 * 8 + 2 * jx) * 66 + tt] | ((unsigned)sl[(c8 * 8 + 2 * jx + 1) * 66 + tt] << 16);
          *(uint4*)(yA + (size_t)(t0 + tt) * DM + c0 + c8 * 8) = make_uint4(w[0], w[1], w[2], w[3]); }
        asm volatile("s_waitcnt lgkmcnt(0)\n\ts_barrier" ::: "memory");
        if (!more) break;
        tile = tn;
    }
}

__device__ __forceinline__ float dot8(const uint4& a, const uint4& b) {
    float d = 0.f;
    const unsigned aw[4] = {a.x, a.y, a.z, a.w}, bw[4] = {b.x, b.y, b.z, b.w};
#pragma unroll
    for (int i = 0; i < 4; ++i) { d += __uint_as_float(aw[i] << 16) * __uint_as_float(bw[i] << 16); d += __uint_as_float(aw[i] & 0xffff0000u) * __uint_as_float(bw[i] & 0xffff0000u); }
    return d; }
__device__ __forceinline__ int t5_bucket(int rel) {
    const int n = rel < 0 ? -rel : rel; const int ret = rel > 0 ? 16 : 0;
    int large = 8 + (int)(logf((float)(n < 1 ? 1 : n) / 8.0f) / logf(128.0f) * 8.0f); large = large > 15 ? 15 : large;
    return ret + (n < 8 ? n : large); }

template <int NSLOT, class F>
__device__ __forceinline__ void naive_attn_one(const bf16_t* __restrict__ proj, int tq, int h, const F& f, bf16_t* __restrict__ yout, int lane) {
    const uint4* qp = (const uint4*)(proj + (size_t)tq * 4096 + h * 64);
    uint4 q[8];
#pragma unroll
    for (int i = 0; i < 8; ++i) q[i] = qp[i];
    float s[NSLOT]; int tk[NSLOT]; float mx = -1e30f;
#pragma unroll
    for (int e = 0; e < NSLOT; ++e) { int tok; float bias; f(e, lane, tok, bias); tk[e] = tok; s[e] = -1e30f;
        if (tok >= 0) { const uint4* kp = (const uint4*)(proj + (size_t)tok * 4096 + 1024 + h * 64); float d = 0.f;
#pragma unroll
            for (int i = 0; i < 8; ++i) d += dot8(q[i], kp[i]);
            s[e] = d * 0.125f + bias; }
        mx = fmaxf(mx, s[e]); }
    mx = wave_max(mx);
    float sum = 0.f;
#pragma unroll
    for (int e = 0; e < NSLOT; ++e) { const float p = tk[e] >= 0 ? __expf(s[e] - mx) : 0.f; s[e] = p; sum += p; }
    sum = wave_sum(sum);
    float o = 0.f;
#pragma unroll
    for (int e = 0; e < NSLOT; ++e) {
        for (int l = 0; l < 64; ++l) { const int t2 = __builtin_amdgcn_readlane(tk[e], l); const float p = __uint_as_float((unsigned)__builtin_amdgcn_readlane((int)__float_as_uint(s[e]), l));
            if (t2 >= 0) o += p * bf2f(proj[(size_t)t2 * 4096 + 2048 + h * 64 + lane]); } }
    o /= sum;
    const float gate = bf2f(proj[(size_t)tq * 4096 + 3072 + h * 64 + lane]);
    yout[(size_t)tq * 1024 + h * 64 + lane] = f2bf(o * silu(gate));
}
struct DilF { int t; int b; int h; const float* rel_bias;
    __device__ __forceinline__ void operator()(int e, int lane, int& tok, float& bias) const {
        const int pi = e / 3, jj = (e % 3) * 64 + lane; const int r = pi == 0 ? 1 : (pi == 1 ? 4 : 16);
        const int rel = (jj - 64) * r, tkk = t + rel;
        if (jj > 128 || tkk < 0 || tkk >= SEQ) { tok = -1; bias = 0.f; return; }
        tok = b * SEQ + tkk; bias = rel_bias[t5_bucket(rel) * 16 + h]; } };
struct NatF { int r, c, b; const float* rpb_h;
    __device__ __forceinline__ void operator()(int e, int lane, int& tok, float& bias) const {
        const int kk = e * 64 + lane, kr = kk >> 4, kc = kk & 15;
        int rs = r - 4; rs = rs < 0 ? 0 : (rs > 56 ? 56 : rs); int cs = c - 8; cs = cs < 0 ? 0 : (cs > 48 ? 48 : cs);
        tok = b * SEQ + (rs + kr) * 64 + cs + kc; bias = rpb_h[(rs + kr - r + 7) * 31 + (cs + kc - c + 15)]; } };
__device__ void ph_dilated_naive(const Params& P, const bf16_t* __restrict__ proj, bf16_t* __restrict__ yout) {
    const int tid = otid(); const int lane = tid & 63, wid = tid >> 6;
    for (int u = blockIdx.x * 8 + wid; u < T_TOK * 16; u += gridDim.x * 8) {
        const int h = u & 15, tq = u >> 4; DilF f{tq & (SEQ - 1), tq >> 12, h, P.in[17]};
        naive_attn_one<9, DilF>(proj, tq, h, f, yout, lane); }
}
__device__ void ph_natten_naive(const Params& P, int j, int half, const bf16_t* __restrict__ proj, bf16_t* __restrict__ yout) {
    const int tid = otid(); const int lane = tid & 63, wid = tid >> 6;
    const float* rpb = P.in[18] + (size_t)j * 32 * 15 * 31;
    for (int u = blockIdx.x * 8 + wid; u < T_TOK * 16; u += gridDim.x * 8) {
        const int h = u & 15, tq = u >> 4, pos = tq & (SEQ - 1); NatF f{pos >> 6, pos & 63, tq >> 12, rpb + (size_t)(half * 16 + h) * 15 * 31};
        naive_attn_one<2, NatF>(proj, tq, h, f, yout, lane); }
}


typedef float f32x16 __attribute__((ext_vector_type(16)));
typedef float f32x8v __attribute__((ext_vector_type(8)));
typedef __bf16 bf16x8n __attribute__((ext_vector_type(8)));
typedef short bf16x8s __attribute__((ext_vector_type(8)));
typedef unsigned u32x4a __attribute__((ext_vector_type(4)));
__device__ __forceinline__ int crow32(int reg, int h) { return (reg & 3) + 8 * (reg >> 2) + 4 * h; }
template <class Pol>
__device__ __forceinline__ void attn_loadk(const bf16_t* __restrict__ kbase, const Pol& pol, int fb, int r, int hh, bf16x8s (&kf)[4]) {
    const int ktr = pol.ktok(fb, r);
#pragma unroll
    for (int s = 0; s < 4; ++s) kf[s] = *(const bf16x8s*)(kbase + ktr * 64 + 16 * s + 8 * hh);
}
template <class Pol>
__device__ __forceinline__ void attn_loadv(const bf16_t* __restrict__ vbase, const Pol& pol, int fb, int r, int hh, u32x4a (&vg)[4]) {
    const int lane = hh * 32 + r;
#pragma unroll
    for (int j = 0; j < 4; ++j) { const int vt = pol.ktok(fb, 8 * j + (lane >> 3)); vg[j] = *(const u32x4a*)(vbase + vt * 64 + (lane & 7) * 8); }
}
template <class Pol>
__device__ __forceinline__ void attn_compute(const bf16_t* __restrict__ kbase, const Pol& pol, int fb, int fbn, bool first, int r, int hh, int xaddr, const bf16x8s (&qf)[4], bf16x8s (&kf)[4], u32x4a (&vg)[4], const bf16_t* __restrict__ vbase, LAS unsigned char* wl,
                                             f32x16& o0, f32x16& o1, float& m_run, float& l_run) {
    f32x16 sc;
#pragma unroll
    for (int i = 0; i < 16; ++i) sc[i] = 0.f;
#pragma unroll
    for (int s = 0; s < 4; ++s) sc = __builtin_amdgcn_mfma_f32_32x32x16_bf16(kf[s], qf[s], sc, 0, 0, 0);
    attn_loadk<Pol>(kbase, pol, fbn, r, hh, kf);
    pol.scores(fb, r, hh, sc);
    if (first) { float bm = sc[0];
#pragma unroll
        for (int i = 1; i < 16; ++i) bm = fmaxf(bm, sc[i]);
        bm = fmaxf(bm, bperm_f(xaddr, bm)); m_run = fmaxf(bm, -40.0f); }
    float psum = 0.f;
#pragma unroll
    for (int i = 0; i < 16; ++i) { const float p = __builtin_amdgcn_exp2f(sc[i] - m_run); sc[i] = p; psum += p; }
    l_run += psum;
    { const int lane = hh * 32 + r;
      asm volatile("" ::: "memory");
#pragma unroll
      for (int j = 0; j < 4; ++j) *(LAS u32x4a*)(wl + (8 * j + (lane >> 3)) * 144 + (lane & 7) * 16) = vg[j];
      asm volatile("" ::: "memory"); }
    attn_loadv<Pol>(vbase, pol, fbn, r, hh, vg);
    u32x4a va[2], vb[2];
    { const LAS unsigned short* rp = (const LAS unsigned short*)(wl + (4 * hh) * 144 + r * 2);
#pragma unroll
      for (int s = 0; s < 2; ++s)
#pragma unroll
        for (int jx = 0; jx < 4; ++jx) { const int k0 = 16 * s + 8 * ((2 * jx) >> 2) + ((2 * jx) & 3), k1 = k0 + 1;
            va[s][jx] = (unsigned)rp[k0 * 72] | ((unsigned)rp[k1 * 72] << 16); vb[s][jx] = (unsigned)rp[k0 * 72 + 32] | ((unsigned)rp[k1 * 72 + 32] << 16); } }
#pragma unroll
    for (int s = 0; s < 2; ++s) { f32x8v t;
#pragma unroll
        for (int jx = 0; jx < 8; ++jx) t[jx] = sc[8 * s + jx];
        const bf16x8s pf = __builtin_bit_cast(bf16x8s, __builtin_convertvector(t, bf16x8n));
        o0 = __builtin_amdgcn_mfma_f32_32x32x16_bf16(__builtin_bit_cast(bf16x8s, va[s]), pf, o0, 0, 0, 0);
        o1 = __builtin_amdgcn_mfma_f32_32x32x16_bf16(__builtin_bit_cast(bf16x8s, vb[s]), pf, o1, 0, 0, 0); }
}
__device__ __forceinline__ void attn_store_out(const f32x16& o0, const f32x16& o1, float inv, const bf16_t* __restrict__ gbase, int qt, bf16_t* __restrict__ yout, int b, int h, int hh) {
    uint2 gws[2][4];
#pragma unroll
    for (int dt = 0; dt < 2; ++dt)
#pragma unroll
        for (int g = 0; g < 4; ++g) { typedef unsigned ntu2_t __attribute__((ext_vector_type(2))); const ntu2_t t_ = __builtin_nontemporal_load((const ntu2_t*)(gbase + qt * 64 + dt * 32 + 8 * g + 4 * hh)); gws[dt][g] = make_uint2(t_.x, t_.y); }
#pragma unroll
    for (int dt = 0; dt < 2; ++dt)
#pragma unroll
        for (int g = 0; g < 4; ++g) { const int d0 = dt * 32 + 8 * g + 4 * hh;
            const uint2 gw = gws[dt][g];
            const float g0 = __uint_as_float(gw.x << 16), g1 = __uint_as_float(gw.x & 0xffff0000u), g2 = __uint_as_float(gw.y << 16), g3 = __uint_as_float(gw.y & 0xffff0000u);
            const float v0 = (dt ? o1[4 * g] : o0[4 * g]) * inv, v1 = (dt ? o1[4 * g + 1] : o0[4 * g + 1]) * inv, v2 = (dt ? o1[4 * g + 2] : o0[4 * g + 2]) * inv, v3 = (dt ? o1[4 * g + 3] : o0[4 * g + 3]) * inv;
            uint2 w; w.x = (unsigned)f2bf(v0 * silu(g0)) | ((unsigned)f2bf(v1 * silu(g1)) << 16); w.y = (unsigned)f2bf(v2 * silu(g2)) | ((unsigned)f2bf(v3 * silu(g3)) << 16);
            *(uint2*)(yout + (size_t)(b * SEQ + qt) * 1024 + h * 64 + d0) = w; }
}
template <class Pol, int MODE>
__device__ __forceinline__ void attn_wave_task(const bf16_t* __restrict__ proj, int b, int h, Pol pol, bf16_t* __restrict__ yout, int lane, float* __restrict__ X, LAS unsigned char* wl) {
    const int r = lane & 31, hh = lane >> 5, xaddr = (lane ^ 32) << 2;
    pol.init(r, hh);
    const int qt = pol.qtok(r);
    const bf16_t* qbase = proj + (size_t)(b * 16 + h) * (4096 * 64); const bf16_t* kbase = qbase + (size_t)T_TOK * 1024; const bf16_t* vbase = kbase + (size_t)T_TOK * 1024; const bf16_t* gbase = vbase + (size_t)T_TOK * 1024;
    bf16x8s qf[4];
#pragma unroll
    for (int s = 0; s < 4; ++s) qf[s] = __builtin_nontemporal_load((const bf16x8s*)(qbase + qt * 64 + 16 * s + 8 * hh));
    f32x16 o0, o1;
    float m_run = -40.0f, l_run = 0.f;
    if (MODE == 2) { const float* xr = X + (size_t)pol.xrow(r) * 68;
#pragma unroll
        for (int g = 0; g < 4; ++g) { const float4 a0 = *(const float4*)(xr + 8 * g + 4 * hh), a1 = *(const float4*)(xr + 32 + 8 * g + 4 * hh);
            o0[4 * g] = a0.x; o0[4 * g + 1] = a0.y; o0[4 * g + 2] = a0.z; o0[4 * g + 3] = a0.w; o1[4 * g] = a1.x; o1[4 * g + 1] = a1.y; o1[4 * g + 2] = a1.z; o1[4 * g + 3] = a1.w; }
        m_run = xr[64]; l_run = hh == 0 ? xr[65] : 0.f;
    } else {
#pragma unroll
        for (int i = 0; i < 16; ++i) { o0[i] = 0.f; o1[i] = 0.f; } }
    constexpr int NB = Pol::NB;
    bf16x8s kf[4]; u32x4a vfA[4];
    attn_loadk<Pol>(kbase, pol, 0, r, hh, kf);
    attn_loadv<Pol>(vbase, pol, 0, r, hh, vfA);
#pragma unroll 1
    for (int fb = 0; fb < NB; ++fb)
        attn_compute<Pol>(kbase, pol, fb, fb + 1 < NB ? fb + 1 : NB - 1, (MODE != 2) && (fb == 0), r, hh, xaddr, qf, kf, vfA, vbase, wl, o0, o1, m_run, l_run);
    l_run += bperm_f(xaddr, l_run);
    if (MODE == 1) { float* xr = X + (size_t)pol.xrow(r) * 68;
#pragma unroll
        for (int g = 0; g < 4; ++g) { *(float4*)(xr + 8 * g + 4 * hh) = make_float4(o0[4 * g], o0[4 * g + 1], o0[4 * g + 2], o0[4 * g + 3]);
            *(float4*)(xr + 32 + 8 * g + 4 * hh) = make_float4(o1[4 * g], o1[4 * g + 1], o1[4 * g + 2], o1[4 * g + 3]); }
        if (hh == 0) { xr[64] = m_run; xr[65] = l_run; }
        return; }
    attn_store_out(o0, o1, 1.0f / l_run, gbase, qt, yout, b, h, hh);
}
#define SC2 (0.125f * 1.44269504088896341f)
#define CI32(i) (((i) & 3) + 8 * ((i) >> 2))
struct DilPolA { static constexpr int NB = 13; int t0, xq0; const LAS float* tbl16; const LAS float* tbl4;
    __device__ __forceinline__ void init(int, int) {}
    __device__ __forceinline__ int qtok(int n) const { return t0 + 16 * n; }
    __device__ __forceinline__ int xrow(int n) const { return xq0 + 16 * n; }
    __device__ __forceinline__ int stride(int fb) const { return fb < 5 ? 16 : 4; }
    __device__ __forceinline__ int kbof(int fb) const { return fb < 5 ? fb : fb - 5; }
    __device__ __forceinline__ int ktok(int fb, int ks) const { int t = t0 + stride(fb) * (-64 + 32 * kbof(fb) + ks); t = t < 0 ? 0 : (t > SEQ - 1 ? SEQ - 1 : t); return t; }
    __device__ __forceinline__ void scores(int fb, int n, int hh, f32x16& sc) const {
        const int st = stride(fb), kb = kbof(fb);
        const int brel = st * (-64 + 32 * kb + 4 * hh) - 16 * n, bidx = brel + 1536, tkb = t0 + st * (-64 + 32 * kb + 4 * hh);
        const int tlo = t0 + st * (-64 + 32 * kb); const bool edge = (tlo < 0) || (tlo + 31 * st > SEQ - 1);
        if (fb < 5) { const LAS float* tp = tbl16 + bidx + (bidx >> 4);
#pragma unroll
            for (int i = 0; i < 16; ++i) { float v = sc[i] * SC2 + tp[17 * CI32(i)]; if (edge) v = ((unsigned)(tkb + 16 * CI32(i)) < (unsigned)SEQ) ? v : -1e30f; sc[i] = v; }
        } else { const LAS float* tp = tbl4 + bidx + (bidx >> 4);
#pragma unroll
            for (int i = 0; i < 16; ++i) { float v = sc[i] * SC2 + tp[4 * CI32(i) + (CI32(i) >> 2)]; if (edge) v = ((unsigned)(tkb + 4 * CI32(i)) < (unsigned)SEQ) ? v : -1e30f; sc[i] = v; } }
        } };
struct DilPolB { static constexpr int NB = 5; int q0, xq0; const LAS float* tblB;
    __device__ __forceinline__ void init(int, int) {}
    __device__ __forceinline__ int qtok(int n) const { return q0 + n; }
    __device__ __forceinline__ int xrow(int n) const { return xq0 + n; }
    __device__ __forceinline__ int ktok(int fb, int ks) const { int t = q0 - 64 + 32 * fb + ks; t = t < 0 ? 0 : (t > SEQ - 1 ? SEQ - 1 : t); return t; }
    __device__ __forceinline__ void scores(int fb, int n, int hh, f32x16& sc) const {
        const int tlo = q0 - 64 + 32 * fb; const bool edge = (tlo < 0) || (tlo + 31 > SEQ - 1);
        const LAS float* tp = tblB + (-64 + 32 * fb + 4 * hh - n + 96); const int tkb = tlo + 4 * hh;
#pragma unroll
        for (int i = 0; i < 16; ++i) { float v = sc[i] * SC2 + tp[CI32(i)]; if (edge) v = ((unsigned)(tkb + CI32(i)) < (unsigned)SEQ) ? v : -1e30f; sc[i] = v; }
        } };
struct NatPol { static constexpr int NB = 9; int r0, c0, rs0, cw0; const LAS float* rpbh; int colmask, cbase, rq, rsq;
    __device__ __forceinline__ int xrow(int) const { return 0; }
    __device__ __forceinline__ void init(int n, int hh) { rq = r0 + (n >> 4); const int cq = c0 + (n & 15); rsq = rq - 4; rsq = rsq < 0 ? 0 : (rsq > 56 ? 56 : rsq); int csq = cq - 8; csq = csq < 0 ? 0 : (csq > 48 ? 48 : csq);
        cbase = cw0 + 4 * hh - cq + 15; int m = 0;
#pragma unroll
        for (int i = 0; i < 16; ++i) { const int ck = cw0 + 4 * hh + CI32(i); m |= (ck >= csq && ck < csq + 16) ? (1 << i) : 0; }
        colmask = m; }
    __device__ __forceinline__ int qtok(int n) const { return (r0 + (n >> 4)) * 64 + c0 + (n & 15); }
    __device__ __forceinline__ int ktok(int kb, int ks) const { int rk = rs0 + kb; rk = rk > 63 ? 63 : rk; return rk * 64 + cw0 + ks; }
    __device__ __forceinline__ void scores(int kb, int, int, f32x16& sc) const {
        const int rk = rs0 + kb; const bool rowok = rk >= rsq && rk < rsq + 8 && rk < 64; const int em = rowok ? colmask : 0;
        int ro = rk - rq + 7; ro = ro < 0 ? 0 : (ro > 14 ? 14 : ro); const LAS float* tp = rpbh + ro * 31 + cbase;
        float bv[16];
#pragma unroll
        for (int i = 0; i < 16; ++i) bv[i] = tp[CI32(i)];
#pragma unroll
        for (int i = 0; i < 16; ++i) { const float v = sc[i] * SC2 + bv[i]; sc[i] = (em & (1 << i)) ? v : -1e30f; }
        } };
__device__ __forceinline__ void natten_wave_task2(const bf16_t* __restrict__ proj, int b, int h, NatPol pA, NatPol pB, bf16_t* __restrict__ yout, int lane, LAS unsigned char* wl) {
    const int r = lane & 31, hh = lane >> 5, xaddr = (lane ^ 32) << 2;
    pA.init(r, hh); pB.init(r, hh);
    const int qtA = pA.qtok(r), qtB = pB.qtok(r);
    const bf16_t* qbase = proj + (size_t)(b * 16 + h) * (4096 * 64); const bf16_t* kbase = qbase + (size_t)T_TOK * 1024; const bf16_t* vbase = kbase + (size_t)T_TOK * 1024; const bf16_t* gbase = vbase + (size_t)T_TOK * 1024;
    bf16x8s qA[4], qB[4];
#pragma unroll
    for (int s = 0; s < 4; ++s) { qA[s] = __builtin_nontemporal_load((const bf16x8s*)(qbase + qtA * 64 + 16 * s + 8 * hh)); qB[s] = __builtin_nontemporal_load((const bf16x8s*)(qbase + qtB * 64 + 16 * s + 8 * hh)); }
    f32x16 oA0, oA1, oB0, oB1;
#pragma unroll
    for (int i = 0; i < 16; ++i) { oA0[i] = 0.f; oA1[i] = 0.f; oB0[i] = 0.f; oB1[i] = 0.f; }
    float mA = -40.0f, lA = 0.f, mB = -40.0f, lB = 0.f;
    constexpr int NB = 11;
    bf16x8s kf[4]; u32x4a vg[4];
    attn_loadk<NatPol>(kbase, pA, 0, r, hh, kf);
    attn_loadv<NatPol>(vbase, pA, 0, r, hh, vg);
#pragma unroll 1
    for (int fb = 0; fb < NB; ++fb) {
        const int fbn = fb + 1 < NB ? fb + 1 : NB - 1;
        f32x16 scA, scB;
#pragma unroll
        for (int i = 0; i < 16; ++i) { scA[i] = 0.f; scB[i] = 0.f; }
#pragma unroll
        for (int s = 0; s < 4; ++s) { scA = __builtin_amdgcn_mfma_f32_32x32x16_bf16(kf[s], qA[s], scA, 0, 0, 0); scB = __builtin_amdgcn_mfma_f32_32x32x16_bf16(kf[s], qB[s], scB, 0, 0, 0); }
        attn_loadk<NatPol>(kbase, pA, fbn, r, hh, kf);
        pA.scores(fb, r, hh, scA); pB.scores(fb, r, hh, scB);
        if (fb == 0) { float ba = scA[0], bb = scB[0];
#pragma unroll
            for (int i = 1; i < 16; ++i) { ba = fmaxf(ba, scA[i]); bb = fmaxf(bb, scB[i]); }
            ba = fmaxf(ba, bperm_f(xaddr, ba)); bb = fmaxf(bb, bperm_f(xaddr, bb)); mA = fmaxf(ba, -40.0f); mB = fmaxf(bb, -40.0f); }
        float psA = 0.f, psB = 0.f;
#pragma unroll
        for (int i = 0; i < 16; ++i) { const float pa = __builtin_amdgcn_exp2f(scA[i] - mA); scA[i] = pa; psA += pa; const float pb = __builtin_amdgcn_exp2f(scB[i] - mB); scB[i] = pb; psB += pb; }
        lA += psA; lB += psB;
        { asm volatile("" ::: "memory");
#pragma unroll
          for (int j = 0; j < 4; ++j) *(LAS u32x4a*)(wl + (8 * j + (lane >> 3)) * 144 + (lane & 7) * 16) = vg[j];
          asm volatile("" ::: "memory"); }
        attn_loadv<NatPol>(vbase, pA, fbn, r, hh, vg);
        u32x4a va[2], vb[2];
        { const LAS unsigned short* rp = (const LAS unsigned short*)(wl + (4 * hh) * 144 + r * 2);
#pragma unroll
          for (int s = 0; s < 2; ++s)
#pragma unroll
            for (int jx = 0; jx < 4; ++jx) { const int k0 = 16 * s + 8 * ((2 * jx) >> 2) + ((2 * jx) & 3), k1 = k0 + 1;
                va[s][jx] = (unsigned)rp[k0 * 72] | ((unsigned)rp[k1 * 72] << 16); vb[s][jx] = (unsigned)rp[k0 * 72 + 32] | ((unsigned)rp[k1 * 72 + 32] << 16); } }
#pragma unroll
        for (int s = 0; s < 2; ++s) { f32x8v ta, tb;
#pragma unroll
            for (int jx = 0; jx < 8; ++jx) { ta[jx] = scA[8 * s + jx]; tb[jx] = scB[8 * s + jx]; }
            const bf16x8s pfa = __builtin_bit_cast(bf16x8s, __builtin_convertvector(ta, bf16x8n)), pfb = __builtin_bit_cast(bf16x8s, __builtin_convertvector(tb, bf16x8n));
            oA0 = __builtin_amdgcn_mfma_f32_32x32x16_bf16(__builtin_bit_cast(bf16x8s, va[s]), pfa, oA0, 0, 0, 0);
            oA1 = __builtin_amdgcn_mfma_f32_32x32x16_bf16(__builtin_bit_cast(bf16x8s, vb[s]), pfa, oA1, 0, 0, 0);
            oB0 = __builtin_amdgcn_mfma_f32_32x32x16_bf16(__builtin_bit_cast(bf16x8s, va[s]), pfb, oB0, 0, 0, 0);
            oB1 = __builtin_amdgcn_mfma_f32_32x32x16_bf16(__builtin_bit_cast(bf16x8s, vb[s]), pfb, oB1, 0, 0, 0); }
    }
    lA += bperm_f(xaddr, lA); lB += bperm_f(xaddr, lB);
    attn_store_out(oA0, oA1, 1.0f / lA, gbase, qtA, yout, b, h, hh);
    attn_store_out(oB0, oB1, 1.0f / lB, gbase, qtB, yout, b, h, hh);
}
__device__ void ph_dilated_mfma(const Params& P, const bf16_t* __restrict__ proj, bf16_t* __restrict__ yout, unsigned char* lds_raw, float* __restrict__ Xall) {
    const int tid = otid(); const int lane = tid & 63, wid = tid >> 6;
    LAS float* tbl = (LAS float*)lds_raw; LAS unsigned char* wl = (LAS unsigned char*)lds_raw + 32768 + wid * 4608;
    const float* rel_bias = P.in[17];
    const int G = gridDim.x, bid = blockIdx.x, vb = (G % 8 == 0) ? (bid & 7) * (G >> 3) + (bid >> 3) : bid;
    float* X = Xall + (size_t)bid * 512 * 68;
#pragma unroll 1
    for (int bt = vb; bt < 1024; bt += G) {
        const int p = bt >> 3, chunk = bt & 7, b = p >> 4, h = p & 15;
        __syncthreads();
        LAS float* tbl16 = tbl; LAS float* tbl4 = tbl + 3328; LAS float* tblB = tbl + 6656;
        for (int x = tid; x < 3073; x += NT) { const int rel = x - 1536, ar = rel < 0 ? -rel : rel; const float bv = rel_bias[t5_bucket(rel) * 16 + h] * 1.44269504088896341f;
            tbl16[x + (x >> 4)] = ((rel & 15) == 0 && ar <= 1024) ? bv : -1e30f; tbl4[x + (x >> 4)] = ((rel & 3) == 0 && ar <= 256) ? bv : -1e30f; }
        for (int x = tid; x < 256; x += NT) { const int rel = x - 96, ar = rel < 0 ? -rel : rel; tblB[x] = (ar <= 64) ? rel_bias[t5_bucket(rel) * 16 + h] * 1.44269504088896341f : -1e30f; }
        __syncthreads();
#pragma unroll 1
        for (int rr = 0; rr < 2; ++rr) { const int res = wid * 2 + rr; DilPolA pol{chunk * 512 + res, res, tbl16, tbl4}; attn_wave_task<DilPolA, 1>(proj, b, h, pol, yout, lane, X, wl); }
        __syncthreads();
#pragma unroll 1
        for (int rr = 0; rr < 2; ++rr) { const int qs = (wid * 2 + rr) * 32; DilPolB pol{chunk * 512 + qs, qs, tblB}; attn_wave_task<DilPolB, 2>(proj, b, h, pol, yout, lane, X, wl); }
    }
}
__device__ void ph_natten_mfma(const Params& P, int j, int half, const bf16_t* __restrict__ proj, bf16_t* __restrict__ yout, unsigned char* lds_raw) {
    const int tid = otid(); const int lane = tid & 63, wid = tid >> 6;
    LAS float* tbl = (LAS float*)lds_raw; LAS unsigned char* wl = (LAS unsigned char*)lds_raw + 32768 + wid * 4608;
    const float* rpb = P.in[18] + (size_t)j * 32 * 15 * 31;
    const int G = gridDim.x, bid = blockIdx.x, vb = (G % 8 == 0) ? (bid & 7) * (G >> 3) + (bid >> 3) : bid;
#pragma unroll 1
    for (int id0 = vb * 8; id0 < 8192; id0 += G * 8) {
        const int p = id0 >> 6, b = p >> 4, h = p & 15, wt = (id0 & 63) + wid;
        __syncthreads();
        for (int x = tid; x < 465; x += NT) tbl[64 + x] = rpb[(size_t)(half * 16 + h) * 465 + x] * 1.44269504088896341f;
        __syncthreads();
        const int r0 = (wt >> 2) * 4, c0 = (wt & 3) * 16;
        int rs0 = r0 - 4; rs0 = rs0 < 0 ? 0 : (rs0 > 56 ? 56 : rs0); int cw0 = c0 - 8; cw0 = cw0 < 0 ? 0 : (cw0 > 32 ? 32 : cw0);
        NatPol polA{r0, c0, rs0, cw0, tbl + 64, 0, 0, 0, 0}, polB{r0 + 2, c0, rs0, cw0, tbl + 64, 0, 0, 0, 0};
        natten_wave_task2(proj, b, h, polA, polB, yout, lane, wl);
    }
}

__device__ __forceinline__ void unpack8(const uint4& w, float (&f)[8]) {
    f[0] = __uint_as_float(w.x << 16); f[1] = __uint_as_float(w.x & 0xffff0000u); f[2] = __uint_as_float(w.y << 16); f[3] = __uint_as_float(w.y & 0xffff0000u);
    f[4] = __uint_as_float(w.z << 16); f[5] = __uint_as_float(w.z & 0xffff0000u); f[6] = __uint_as_float(w.w << 16); f[7] = __uint_as_float(w.w & 0xffff0000u); }
__device__ void ph_post(const float* hin_f, const bf16_t* hin_b, const bf16_t* t1, const float* gpost, bf16_t* E, const float* gple, bf16_t* h1b) {
    const int tid = otid(); const int lane = tid & 63, wid = tid >> 6;
    for (int row = blockIdx.x * 8 + wid; row < T_TOK; row += gridDim.x * 8) {
        const size_t ro = (size_t)row * DM;
        uint4 tw[2], ew[2]; float hv[2][8];
#pragma unroll
        for (int i = 0; i < 2; ++i) { const int e0 = (lane + 64 * i) * 8; tw[i] = ntld_u4(t1 + ro + e0); ew[i] = ntld_u4(E + ro + e0); }
        if (hin_b) {
#pragma unroll
            for (int i = 0; i < 2; ++i) { const uint4 hw = ntld_u4(hin_b + ro + (lane + 64 * i) * 8); unpack8(hw, hv[i]); }
        } else {
#pragma unroll
            for (int i = 0; i < 2; ++i) { const int e0 = (lane + 64 * i) * 8; const float4 a = ntld_f4(hin_f + ro + e0), b = ntld_f4(hin_f + ro + e0 + 4);
                hv[i][0] = a.x; hv[i][1] = a.y; hv[i][2] = a.z; hv[i][3] = a.w; hv[i][4] = b.x; hv[i][5] = b.y; hv[i][6] = b.z; hv[i][7] = b.w; } }
        float tv[2][8], ev[2][8]; float ss = 0.f, se = 0.f;
#pragma unroll
        for (int i = 0; i < 2; ++i) { unpack8(tw[i], tv[i]); unpack8(ew[i], ev[i]);
#pragma unroll
            for (int k = 0; k < 8; ++k) { ss += tv[i][k] * tv[i][k]; se += ev[i][k] * ev[i][k]; } }
        ss = wave_sum(ss); se = wave_sum(se);
        const float r = rsqrtf(ss * (1.0f / DM) + RMS_EPS), re = rsqrtf(se * (1.0f / DM) + RMS_EPS);
        float4 gaa[2], gbb[2], paa[2], pbb[2];
#pragma unroll
        for (int i = 0; i < 2; ++i) { const int e0 = (lane + 64 * i) * 8; gaa[i] = *(const float4*)(gpost + e0); gbb[i] = *(const float4*)(gpost + e0 + 4); paa[i] = *(const float4*)(gple + e0); pbb[i] = *(const float4*)(gple + e0 + 4); }
#pragma unroll
        for (int i = 0; i < 2; ++i) { const int e0 = (lane + 64 * i) * 8;
            const float4 ga = gaa[i], gb = gbb[i], pa = paa[i], pb = pbb[i];
            const float gg[8] = {ga.x, ga.y, ga.z, ga.w, gb.x, gb.y, gb.z, gb.w}, pp[8] = {pa.x, pa.y, pa.z, pa.w, pb.x, pb.y, pb.z, pb.w};
            float o[8], x[8];
#pragma unroll
            for (int k = 0; k < 8; ++k) { o[k] = hv[i][k] + tv[i][k] * r * gg[k]; x[k] = ev[i][k] * re * pp[k]; }
            uint4 w; w.x = pg8::cvt_pk_bf16(o[0], o[1]); w.y = pg8::cvt_pk_bf16(o[2], o[3]); w.z = pg8::cvt_pk_bf16(o[4], o[5]); w.w = pg8::cvt_pk_bf16(o[6], o[7]);
            *(uint4*)(h1b + ro + e0) = w;
            uint4 xx; xx.x = pg8::cvt_pk_bf16(x[0], x[1]); xx.y = pg8::cvt_pk_bf16(x[2], x[3]); xx.z = pg8::cvt_pk_bf16(x[4], x[5]); xx.w = pg8::cvt_pk_bf16(x[6], x[7]);
            *(uint4*)(E + ro + e0) = xx; }
    }
}

#define XB_TMO      128
#define XB_XCNT(j)  (256  + 64 * (j))
#define XB_XSUB(j)  (1280 + 64 * (j))
#define XB_XGEN(j)  (2304 + 64 * (j))
#define XB_TOP      3328
#define XB_TOPGEN   3392
#define XCD_BAR_WORDS 3456
#define XB_SPIN_CAP (1u << 18)
__device__ __forceinline__ unsigned xb_ld(unsigned* p)              { return __hip_atomic_load(p, __ATOMIC_RELAXED, __HIP_MEMORY_SCOPE_AGENT); }
__device__ __forceinline__ unsigned xb_add(unsigned* p, unsigned v) { return __hip_atomic_fetch_add(p, v, __ATOMIC_RELAXED, __HIP_MEMORY_SCOPE_AGENT); }
__device__ __forceinline__ unsigned xb_xcc_id() { return (unsigned)__builtin_amdgcn_s_getreg((3 << 11) | 20) & 0xFu; }
#define XB_SPIN(cond, bar) do { unsigned _sp = 0; while (cond) { __builtin_amdgcn_s_sleep(1); \
    if ((++_sp & 255u) == 0u) { if (xb_ld(&(bar)[XB_TMO])) break; if (_sp > XB_SPIN_CAP) { atomicAdd(&(bar)[XB_TMO], 1u); break; } } } } while (0)
struct XcdBarrier { unsigned* bar; unsigned x; volatile LAS unsigned* st; };
__device__ __forceinline__ XcdBarrier xcd_barrier_post(unsigned* bar, volatile LAS unsigned* st) {
    XcdBarrier b; b.bar = bar; b.x = xb_xcc_id(); b.st = st;
    if (threadIdx.x == 0) (void)xb_add(&bar[XB_XCNT(b.x)], 1u);
    return b;
}
__device__ __forceinline__ void xcd_barrier_complete(unsigned* bar, unsigned x, unsigned& nloc, unsigned& nx) {
    const unsigned G = gridDim.x * gridDim.y * gridDim.z;
    unsigned sum, cnt, mine, sp = 0u;
    for (;;) {
        sum = 0u; cnt = 0u; mine = 0u;
#pragma unroll
        for (unsigned j = 0; j < 16; ++j) { const unsigned c = xb_ld(&bar[XB_XCNT(j)]); sum += c; cnt += (c > 0u) ? 1u : 0u; mine = (j == x) ? c : mine; }
        if (sum == G) break;
        __builtin_amdgcn_s_sleep(1);
        if ((++sp & 255u) == 0u) { if (xb_ld(&bar[XB_TMO])) break; if (sp > XB_SPIN_CAP) { atomicAdd(&bar[XB_TMO], 1u); break; } }
    }
    nloc = mine > 0u ? mine : 1u; nx = cnt > 0u ? cnt : 1u;
}
__device__ __forceinline__ void xcd_barrier(const XcdBarrier& b) {
    asm volatile("s_waitcnt vmcnt(0)" ::: "memory");
    __syncthreads();
    if (threadIdx.x == 0) {
        unsigned* bar = b.bar;
        __builtin_amdgcn_s_waitcnt(0);
        unsigned nloc = b.st[0], nx = b.st[1];
        if (nloc == 0u) { xcd_barrier_complete(bar, b.x, nloc, nx); b.st[0] = nloc; b.st[1] = nx; }
        const unsigned old = xb_add(&bar[XB_XSUB(b.x)], 1u);
        const unsigned gen = old / nloc;
        if (old + 1u == (gen + 1u) * nloc) {
            __builtin_amdgcn_fence(__ATOMIC_RELEASE, "agent");
            asm volatile("s_waitcnt vmcnt(0)" ::: "memory");
            const unsigned og = xb_add(&bar[XB_TOP], 1u);
            const unsigned tg = og / nx;
            if (og + 1u == (tg + 1u) * nx) xb_add(&bar[XB_TOPGEN], 1u);
            else XB_SPIN(xb_ld(&bar[XB_TOPGEN]) == tg, bar);
            __builtin_amdgcn_fence(__ATOMIC_ACQUIRE, "agent");
            xb_add(&bar[XB_XGEN(b.x)], 1u);
            asm volatile("s_waitcnt vmcnt(0)" ::: "memory");
        } else {
            XB_SPIN(xb_ld(&bar[XB_XGEN(b.x)]) == gen, bar);
            __builtin_amdgcn_fence(__ATOMIC_ACQUIRE, "agent");
            asm volatile("s_waitcnt vmcnt(0)" ::: "memory");
        }
    }
    __syncthreads();
}
__device__ __forceinline__ void grid_bar(unsigned* ctr, unsigned& epoch, unsigned G) {
    __syncthreads();
    if (threadIdx.x == 0) {
        epoch += 1u;
        __threadfence();
        __hip_atomic_fetch_add(ctr, 1u, __ATOMIC_RELAXED, __HIP_MEMORY_SCOPE_AGENT);
        const unsigned target = epoch * G;
        while (__hip_atomic_load(ctr, __ATOMIC_RELAXED, __HIP_MEMORY_SCOPE_AGENT) < target) __builtin_amdgcn_s_sleep(1);
        __threadfence();
    }
    __syncthreads();
}
__global__ void __launch_bounds__(NT) fwd_megakernel(Params P) {
    extern __shared__ __attribute__((aligned(16))) unsigned char lds_raw[];
    cg::grid_group grid = cg::this_grid();
    PG8_LAS unsigned char* lds = (PG8_LAS unsigned char*)lds_raw;
    float* sl = (float*)lds_raw;
    unsigned char* ws = P.ws;
    const int G = gridDim.x, bid = blockIdx.x;
    bf16_t* U = (bf16_t*)(ws + WS_U); bf16_t* PROJ = (bf16_t*)(ws + WS_PROJ); bf16_t* T1 = (bf16_t*)(ws + WS_T1); bf16_t* E = (bf16_t*)(ws + WS_E);
    bf16_t* YA = (bf16_t*)(ws + WS_YA); bf16_t* YB = (bf16_t*)(ws + WS_YB); float* KF = (float*)(ws + WS_YA);
    bf16_t* WIN = (bf16_t*)(ws + WS_WIN); bf16_t* WOUT = (bf16_t*)(ws + WS_WOUT); bf16_t* PPROJ = (bf16_t*)(ws + WS_PPROJ); bf16_t* PGATE = (bf16_t*)(ws + WS_PGATE);
    bf16_t* PB = (bf16_t*)(ws + WS_PB); float* A3 = (float*)(ws + WS_A3);
    int ph = 0;
    volatile LAS unsigned* xst = (volatile LAS unsigned*)((LAS unsigned char*)lds_raw + 144 * 1024);
    if (threadIdx.x < 4) xst[threadIdx.x] = 0u;
    __syncthreads();
    const XcdBarrier xbar = xcd_barrier_post((unsigned*)(ws + WS_CTL), xst);
#define PHASE_BEGIN if (ph >= P.ph_lo && ph < P.ph_hi) {
#define PHASE_END   if (ph + 1 < P.ph_hi) { if (P.ph_hi < 0) grid.sync(); else xcd_barrier(xbar); } } ++ph;
#pragma unroll 1
    for (int layer = 0; layer < 4; ++layer) {
        const bool even = !(layer & 1); const int j = layer >> 1;
        bf16_t* HBUF = (bf16_t*)P.out;
        PHASE_BEGIN
#pragma unroll 1
            for (int rep = 0; rep < ((REP_MASK & 8) ? 2 : 1); ++rep) {
            if (layer == 0) ph_rmsnorm_rows(P.in[0], P.in[4] + layer * DM, U); else ph_rmsnorm_rows_b16(HBUF, P.in[4] + layer * DM, U);
            ph_prep_weights(P, layer, sl);
            ph_convert_p(P.in[1] + (size_t)layer * T_TOK * PLE, PB);
            if (even) ph_filter_mlp(P, j, A3);
            }
            if (REP_MASK & 16) { for (int rep = 0; rep < 8; ++rep) grid.sync(); }
        PHASE_END
        PHASE_BEGIN
            pg8::StaticOrder S; pg8::Gemm g; pg8::EpiBf16 Ep;
            if (even) { g = pg8::Gemm{WIN, U, 4096, T_TOK, 1024, 1024, 1 << 20, 0ll}; Ep = pg8::EpiBf16{PROJ, (size_t)T_TOK, 0}; S.init(4096, T_TOK, G, bid); }
            else      { g = pg8::Gemm{U, WIN, T_TOK, 4096, 1024, 1024, 1 << 20, 0ll}; Ep = pg8::EpiBf16{PROJ, (size_t)4096, 1}; S.init(T_TOK, 4096, G, bid); }
#pragma unroll 1
            for (int rep = 0; rep < ((REP_MASK & 1) ? 2 : 1); ++rep)
            pg8::gemm_phase<pg8::EpiBf16, pg8::StaticOrder>(lds, g, S, Ep);
#pragma unroll 1
            for (int rep = 0; rep < ((REP_MASK & 32) ? 2 : 1); ++rep)
            if (even) { __syncthreads(); ph_filter_gen(P, j, A3, KF, sl); }
        PHASE_END
        PHASE_BEGIN
            #if HY_FFT
#pragma unroll 1
            for (int rep = 0; rep < ((REP_MASK & 2) ? 2 : 1); ++rep)
            if (even) ph_hyena_fft(P, j, PROJ, KF, YB, lds_raw);
#else
            if (even) ph_hyena_naive(P, j, PROJ, KF, YB, sl);
#endif
#if ATT_MFMA
#pragma unroll 1
            for (int rep = 0; rep < (((REP_MASK & 4) || ((REP_MASK & 64) && !even)) ? 2 : 1); ++rep)
            if (!even) ph_natten_mfma(P, j, 0, PROJ, YA, lds_raw);
#else
            else ph_natten_naive(P, j, 0, PROJ, YA);
#endif
        PHASE_END
        PHASE_BEGIN
            pg8::StaticOrder S; S.init(T_TOK, 4096, G, bid);
            pg8::Gemm g{U, WIN + (size_t)4096 * 1024, T_TOK, 4096, 1024, 1024, 1 << 20, 0ll}; pg8::EpiBf16 Ep{PROJ, (size_t)4096, 1};
#pragma unroll 1
            for (int rep = 0; rep < ((REP_MASK & 1) ? 2 : 1); ++rep)
            pg8::gemm_phase<pg8::EpiBf16, pg8::StaticOrder>(lds, g, S, Ep);
#pragma unroll 1
            for (int rep = 0; rep < ((REP_MASK & 32) ? 2 : 1); ++rep)
            if (even) { __syncthreads(); ph_transpose_ya(YB, YA, (bf16_t*)lds_raw); }
        PHASE_END
        PHASE_BEGIN
#if ATT_MFMA
#pragma unroll 1
            for (int rep = 0; rep < (((REP_MASK & 4) || ((REP_MASK & 64) && !even) || ((REP_MASK & 128) && even)) ? 2 : 1); ++rep) {
            if (even) ph_dilated_mfma(P, PROJ, YB, lds_raw, (float*)(ws + WS_U));
            else ph_natten_mfma(P, j, 1, PROJ, YB, lds_raw);
            }
#else
            if (even) ph_dilated_naive(P, PROJ, YB);
            else ph_natten_naive(P, j, 1, PROJ, YB);
#endif
        PHASE_END
        PHASE_BEGIN
#pragma unroll 1
            for (int qq = 0; qq < ((REP_MASK & 1) ? 4 : 2); ++qq) { const int q = qq & 1;
                pg8::StaticOrder S; S.init(T_TOK, 1024, G, bid);
                pg8::Gemm g = q == 0 ? pg8::Gemm{YA, WOUT, T_TOK, 1024, 2048, 1024, 16, (long long)(WS_YB - WS_YA) - 16ll * 128}
                                     : pg8::Gemm{PB, PPROJ, T_TOK, 1024, 256, 256, 1 << 20, 0ll};
                pg8::EpiBf16 Ep{q == 0 ? T1 : E, (size_t)1024, 0};
                pg8::gemm_phase<pg8::EpiBf16, pg8::StaticOrder>(lds, g, S, Ep);
            }
        PHASE_END
        PHASE_BEGIN
            ph_post(P.in[0], layer == 0 ? (const bf16_t*)nullptr : (const bf16_t*)HBUF, T1, P.in[5] + layer * DM, E, P.in[20] + layer * DM, U);
        PHASE_END
        PHASE_BEGIN
            pg8::StaticOrder S; S.init(T_TOK, 1024, G, bid);
            pg8::Gemm g{U, PGATE, T_TOK, 1024, 1024, 1024, 1 << 20, 0ll}; pg8::EpiGate Ep{U, E, HBUF, layer == 3 ? P.out : (float*)nullptr, 1024};
            pg8::gemm_phase<pg8::EpiGate, pg8::StaticOrder>(lds, g, S, Ep);
        PHASE_END
    }
}

extern "C" void kernel_launch(void* const* d_in, const int* in_sizes, int n_in, void* d_out, int out_size, void* d_ws, size_t ws_size, hipStream_t stream) {
    static int grid_blocks = 0;
    if (grid_blocks == 0) {
        if (n_in != 22 || ws_size < WS_END) { fprintf(stderr, "kernel_launch: unexpected n_in %d / ws_size %zu\n", n_in, ws_size); grid_blocks = -1; return; }
        int dev = 0, cus = 0, per_cu = 0;
        hipGetDevice(&dev); hipDeviceGetAttribute(&cus, hipDeviceAttributeMultiprocessorCount, dev);
        if (hipFuncSetAttribute((const void*)fwd_megakernel, hipFuncAttributeMaxDynamicSharedMemorySize, LDS_BYTES) != hipSuccess) { fprintf(stderr, "hipFuncSetAttribute failed\n"); grid_blocks = -1; return; }
        if (hipOccupancyMaxActiveBlocksPerMultiprocessor(&per_cu, (const void*)fwd_megakernel, NT, LDS_BYTES) != hipSuccess || per_cu < 1) { fprintf(stderr, "occupancy query: %d\n", per_cu); per_cu = 1; }
        (void)hipGetLastError();
        grid_blocks = cus;
    }
    if (grid_blocks < 0) return;
    if (hipMemsetAsync((char*)d_ws + WS_CTL, 0, XCD_BAR_WORDS * 4, stream) != hipSuccess) { fprintf(stderr, "memset failed\n"); return; }
    Params p{};
    for (int i = 0; i < 22; ++i) p.in[i] = (const float*)d_in[i];
    p.out = (float*)d_out; p.ws = (unsigned char*)d_ws; p.ph_lo = 0; p.ph_hi = 32;
    void* args[] = {&p};
    hipError_t e = hipLaunchCooperativeKernel((const void*)fwd_megakernel, dim3(grid_blocks), dim3(NT), args, LDS_BYTES, stream);
    if (e != hipSuccess) fprintf(stderr, "cooperative launch failed: %s (grid %d)\n", hipGetErrorString(e), grid_blocks);
}
```

```cpp
#include <hip/hip_runtime.h>
#include <hip/hip_cooperative_groups.h>
#include <cstdio>
#include <cstdint>
namespace cg = cooperative_groups;

#ifndef REP_MASK
#define REP_MASK 0
#endif
#ifndef HY_FFT
#define HY_FFT 1
#endif
#ifndef ATT_MFMA
#define ATT_MFMA 1
#endif

namespace pg8 {
#define PG8_LAS __attribute__((address_space(3)))
typedef unsigned short bf16_t;
typedef short bf16x8 __attribute__((ext_vector_type(8)));
typedef float f32x4 __attribute__((ext_vector_type(4)));
typedef unsigned u32x4 __attribute__((ext_vector_type(4)));
constexpr int BM = 256, BK = 64, HALF = 128, HTB = HALF * BK * 2, STAGE_BYTES = 8 * HTB, NXCD = 8, WGM = 8;

__host__ __device__ __forceinline__ int lds_byte(int r, int c) { const int st = (r >> 4) * 2 + (c >> 5), rr = r & 15, cc = c & 31, ob = rr * 64 + cc * 2; return st * 1024 + (ob ^ (((ob >> 9) & 1) << 5)); }
__host__ __device__ __forceinline__ void stage_rc(int b, int& R, int& C) { const int st = b / 1024, sb = b % 1024, swz = sb ^ (((sb >> 9) & 1) << 5); R = (st >> 1) * 16 + swz / 64; C = (st & 1) * 32 + (swz % 64) / 2; }
__host__ __device__ __forceinline__ int perm32(int rho) { const int n = rho >> 4, i = rho & 15; return 8 * (i >> 2) + 4 * n + (i & 3); }

struct Unit { int pm, pn; };
struct Gemm { const bf16_t* A; const bf16_t* Bt; int M, N, K, lda, ksplit; long long adj; };

struct StaticOrder {
    int nM, nN, nwg, G, c;
    __host__ __device__ void init(int M, int N, int G_, int c_) { nM = M / BM; nN = N / BM; nwg = nM * nN; G = G_; c = c_; }
    __host__ __device__ bool next(int i, Unit& u) const {
        const long L = (long)i * G + c; if (L >= nwg) return false;
        int wgid = (int)L; { const int q = nwg / NXCD, r = nwg % NXCD, xcd = wgid % NXCD, off = wgid / NXCD; wgid = (xcd < r ? xcd * (q + 1) : r * (q + 1) + (xcd - r) * q) + off; }
        const int nig = WGM * nN, gid = wgid / nig, fm = gid * WGM, gsz = (nM - fm) < WGM ? (nM - fm) : WGM;
        u.pm = fm + ((wgid % nig) % gsz); u.pn = (wgid % nig) / gsz; return true;
    }
};

__device__ __forceinline__ unsigned cvt_pk_bf16(float lo, float hi) { unsigned r; asm volatile("v_cvt_pk_bf16_f32 %0, %1, %2" : "=v"(r) : "v"(lo), "v"(hi)); return r; }

struct EpiF32 {
    static constexpr bool PERM = false;
    float* C; int ldc;
    __device__ __forceinline__ void operator()(const f32x4 (&acc)[2][2][4][2], const Unit& u, int wr, int wc, int fr, int fq) const {
        const int row0 = u.pm * BM + wr * 64 + fr, col0 = u.pn * BM + wc * 32 + 4 * fq;
#pragma unroll
        for (int ai = 0; ai < 2; ++ai)
#pragma unroll
            for (int m = 0; m < 4; ++m) { float* rowp = C + (size_t)(row0 + ai * HALF + m * 16) * ldc + col0;
#pragma unroll
                for (int bj = 0; bj < 2; ++bj)
#pragma unroll
                    for (int n = 0; n < 2; ++n) *(f32x4*)(rowp + bj * HALF + n * 16) = acc[ai][bj][m][n]; }
    }
};
struct EpiBf16 {
    static constexpr bool PERM = true;
    bf16_t* O; size_t ldc; int mode;
    __device__ __forceinline__ size_t rowterm(int row) const { return mode ? ((size_t)(row >> 12) * (16 * 4096 * 64) + (size_t)(row & 4095) * 64) : (size_t)row * ldc; }
    __device__ __forceinline__ size_t colterm(int col) const { return mode ? ((size_t)(col >> 10) * ((size_t)32768 * 1024) + (size_t)((col >> 6) & 15) * (4096 * 64) + (col & 63)) : (size_t)col; }
    __device__ __forceinline__ void operator()(const f32x4 (&acc)[2][2][4][2], const Unit& u, int wr, int wc, int fr, int fq) const {
        const int row0 = u.pm * BM + wr * 64 + fr; const int col0 = u.pn * BM + wc * 32 + 8 * fq;
        const size_t ct0 = colterm(col0), ct1 = colterm(col0 + HALF);
#pragma unroll
        for (int ai = 0; ai < 2; ++ai)
#pragma unroll
            for (int m = 0; m < 4; ++m) { bf16_t* rowp = O + rowterm(row0 + ai * HALF + m * 16);
#pragma unroll
                for (int bj = 0; bj < 2; ++bj) { const f32x4 v0 = acc[ai][bj][m][0], v1 = acc[ai][bj][m][1];
                    u32x4 w; w.x = cvt_pk_bf16(v0[0], v0[1]); w.y = cvt_pk_bf16(v0[2], v0[3]); w.z = cvt_pk_bf16(v1[0], v1[1]); w.w = cvt_pk_bf16(v1[2], v1[3]);
                    *(u32x4*)(rowp + (bj ? ct1 : ct0)) = w; } }
    }
};
struct EpiGate {
    static constexpr bool PERM = true;
    const bf16_t* H1; const bf16_t* E; bf16_t* HB; float* HF; int ldc;
    __device__ __forceinline__ void operator()(const f32x4 (&acc)[2][2][4][2], const Unit& u, int wr, int wc, int fr, int fq) const {
        const int row0 = u.pm * BM + wr * 64 + fr, col0 = u.pn * BM + wc * 32 + 8 * fq;
#pragma unroll
        for (int ai = 0; ai < 2; ++ai) {
            u32x4 hws[4][2], ews[4][2];
#pragma unroll
            for (int m = 0; m < 4; ++m)
#pragma unroll
                for (int bj = 0; bj < 2; ++bj) { const size_t o = (size_t)(row0 + ai * HALF + m * 16) * ldc + col0 + bj * HALF; hws[m][bj] = *(const u32x4*)(H1 + o); ews[m][bj] = *(const u32x4*)(E + o); }
#pragma unroll
            for (int m = 0; m < 4; ++m) { const size_t off = (size_t)(row0 + ai * HALF + m * 16) * ldc + col0;
#pragma unroll
                for (int bj = 0; bj < 2; ++bj) { const size_t o = off + bj * HALF; const u32x4 hw = hws[m][bj]; const u32x4 ew = ews[m][bj];
                    float r[8];
#pragma unroll
                    for (int q = 0; q < 4; ++q) { const float h0 = __uint_as_float(hw[q] << 16), h1 = __uint_as_float(hw[q] & 0xffff0000u), e0 = __uint_as_float(ew[q] << 16), e1 = __uint_as_float(ew[q] & 0xffff0000u);
                        const float g0 = acc[ai][bj][m][q >> 1][(q & 1) * 2], g1 = acc[ai][bj][m][q >> 1][(q & 1) * 2 + 1];
                        r[2 * q] = h0 + e0 * __builtin_amdgcn_rcpf(1.0f + __expf(-g0)); r[2 * q + 1] = h1 + e1 * __builtin_amdgcn_rcpf(1.0f + __expf(-g1)); }
                    if (HF) { *(f32x4*)(HF + o) = (f32x4){r[0], r[1], r[2], r[3]}; *(f32x4*)(HF + o + 4) = (f32x4){r[4], r[5], r[6], r[7]}; }
                    else { u32x4 w; w.x = cvt_pk_bf16(r[0], r[1]); w.y = cvt_pk_bf16(r[2], r[3]); w.z = cvt_pk_bf16(r[4], r[5]); w.w = cvt_pk_bf16(r[6], r[7]); *(u32x4*)(HB + o) = w; } } } }
    }
};

template <class Epi, class Sched, bool ALIGN_EPI = true, bool SP2 = true>
__device__ __forceinline__ void gemm_phase(PG8_LAS unsigned char* lds, const Gemm g, const Sched& S, const Epi& E) {
    int tid_ = threadIdx.x; asm volatile("" : "+v"(tid_));
    const int tid = tid_, wid = __builtin_amdgcn_readfirstlane(tid >> 6), lane = tid & 63, wr = wid >> 2, wc = wid & 3, fr = lane & 15, fq = lane >> 4;
    const int K = g.K, nt = K / BK, lda = g.lda, ksplit = g.ksplit; const long long adj = g.adj;
    unsigned voffA[2], voffB[2];
#pragma unroll
    for (int i = 0; i < 2; ++i) { int R, C; stage_rc(tid * 16 + i * 8192, R, C); const int Rb = Epi::PERM ? ((R & ~31) + perm32(R & 31)) : R;
        voffA[i] = (unsigned)(R * lda + C) * 2u; voffB[i] = (unsigned)(Rb * K + C) * 2u; }
    const size_t kstep = (size_t)(BK * 2);
    const size_t hstepA = (size_t)HALF * lda * 2, hstepB = (size_t)HALF * K * 2;
    const size_t tstepA = 2 * hstepA, tstepB = 2 * hstepB;
    const unsigned ldsw = (unsigned)wid * 1024u;
    const int aoff = lds_byte(wr * 64 + fr, fq * 8), boff = lds_byte(wc * 32 + fr, fq * 8);
#define PG8_SA(b, h) (((b) * 2 + (h)) * HTB)
#define PG8_SB(b, h) ((4 + (b) * 2 + (h)) * HTB)
#define PG8_STAGE(bufoff, gbase, voff) do { _Pragma("unroll") for (int _i = 0; _i < 2; ++_i) \
        __builtin_amdgcn_global_load_lds((const unsigned*)((const char*)(gbase) + (voff)[_i]), (PG8_LAS unsigned*)(lds + (bufoff) + ldsw + _i * 8192), 16, 0, 0); } while (0)
#define PG8_LDA(dst, b, h) do { _Pragma("unroll") for (int m = 0; m < 4; ++m) _Pragma("unroll") for (int k = 0; k < 2; ++k) dst[m][k] = *(const PG8_LAS bf16x8*)(lds + PG8_SA(b, h) + aoff + m * 2048 + k * 1024); } while (0)
#define PG8_LDB(dst, b, h) do { _Pragma("unroll") for (int n = 0; n < 2; ++n) _Pragma("unroll") for (int k = 0; k < 2; ++k) dst[n][k] = *(const PG8_LAS bf16x8*)(lds + PG8_SB(b, h) + boff + n * 2048 + k * 1024); } while (0)
#define PG8_MMA(ai, bj, At, Bt) do { __builtin_amdgcn_s_setprio(1); _Pragma("unroll") for (int m = 0; m < 4; ++m) _Pragma("unroll") for (int n = 0; n < 2; ++n) _Pragma("unroll") for (int k = 0; k < 2; ++k) \
        acc[ai][bj][m][n] = __builtin_amdgcn_mfma_f32_16x16x32_bf16(Bt[n][k], At[m][k], acc[ai][bj][m][n], 0, 0, 0); __builtin_amdgcn_s_setprio(0); } while (0)
#define PG8_WAIT_V(n) asm volatile("s_waitcnt vmcnt(" #n ")" ::: "memory")
#define PG8_WAIT_L(n) asm volatile("s_waitcnt lgkmcnt(" #n ")" ::: "memory")
#define PG8_BAR __builtin_amdgcn_s_barrier()
#define PG8_SCHED __builtin_amdgcn_sched_barrier(0)
#define PG8_ATILE(base, tt) ((base) + (size_t)(tt) * kstep + (((tt) >= ksplit) ? adj : 0ll))
    Unit cur, nxt; int ui = 0;
    if (!S.next(0, cur)) return;
    f32x4 acc[2][2][4][2];
#pragma unroll
    for (int a = 0; a < 2; ++a)
#pragma unroll
        for (int b = 0; b < 2; ++b)
#pragma unroll
            for (int m = 0; m < 4; ++m)
#pragma unroll
                for (int n = 0; n < 2; ++n) acc[a][b][m][n] = (f32x4){0.f, 0.f, 0.f, 0.f};
    bf16x8 At[4][2], B0[2][2], B1[2][2];
    const char* cA = (const char*)g.A + (size_t)cur.pm * tstepA; const char* cB = (const char*)g.Bt + (size_t)cur.pn * tstepB;
    if constexpr (SP2) {
        PG8_STAGE(PG8_SB(0, 0), cB, voffB); PG8_STAGE(PG8_SB(0, 1), cB + hstepB, voffB); PG8_STAGE(PG8_SA(0, 0), cA, voffA); PG8_STAGE(PG8_SA(0, 1), cA + hstepA, voffA);
        if (wr == 1) PG8_BAR;
        PG8_WAIT_V(2); PG8_BAR;
        PG8_STAGE(PG8_SB(1, 0), cB + kstep, voffB); PG8_STAGE(PG8_SA(1, 0), cA + kstep, voffA); PG8_STAGE(PG8_SB(1, 1), cB + hstepB + kstep, voffB);
        PG8_WAIT_V(6); PG8_BAR;
    } else {
    PG8_STAGE(PG8_SB(0, 0), cB, voffB); PG8_STAGE(PG8_SA(0, 0), cA, voffA); PG8_STAGE(PG8_SB(0, 1), cB + hstepB, voffB); PG8_STAGE(PG8_SA(0, 1), cA + hstepA, voffA);
    if (wr == 1) PG8_BAR;
    PG8_WAIT_V(4); PG8_BAR;
    PG8_STAGE(PG8_SB(1, 0), cB + kstep, voffB); PG8_STAGE(PG8_SA(1, 0), cA + kstep, voffA); PG8_STAGE(PG8_SB(1, 1), cB + hstepB + kstep, voffB);
    PG8_WAIT_V(6); PG8_BAR;
    }
    for (;;) {
        const bool has_next = S.next(ui + 1, nxt);
        const char* nA = has_next ? (const char*)g.A + (size_t)nxt.pm * tstepA : cA; const char* nB = has_next ? (const char*)g.Bt + (size_t)nxt.pn * tstepB : cB;
        for (int t = 0; t < nt; t += 2) {
            const bool last = (t == nt - 2);
            const char* a1 = PG8_ATILE(cA, t + 1);
            const char* a2 = last ? nA : PG8_ATILE(cA, t + 2); const char* b2 = last ? nB : cB + (size_t)(t + 2) * kstep;
            const char* a3 = a2 + kstep; const char* b3 = b2 + kstep;
            if constexpr (SP2) {
            PG8_LDB(B0, 0, 0); PG8_LDB(B1, 0, 1); PG8_SCHED; PG8_LDA(At, 0, 0); PG8_STAGE(PG8_SA(1, 1), a1 + hstepA, voffA);
            PG8_WAIT_V(8); PG8_WAIT_L(0); PG8_BAR; PG8_MMA(0, 0, At, B0); PG8_MMA(0, 1, At, B1); PG8_BAR; PG8_SCHED;
            PG8_LDA(At, 0, 1); PG8_STAGE(PG8_SB(0, 0), b2, voffB); PG8_STAGE(PG8_SB(0, 1), b2 + hstepB, voffB); PG8_STAGE(PG8_SA(0, 0), a2, voffA);
            PG8_WAIT_V(8); PG8_WAIT_L(0); PG8_BAR; PG8_MMA(1, 0, At, B0); PG8_MMA(1, 1, At, B1); PG8_BAR; PG8_SCHED;
            PG8_LDB(B0, 1, 0); PG8_LDB(B1, 1, 1); PG8_SCHED; PG8_LDA(At, 1, 0); PG8_STAGE(PG8_SA(0, 1), a2 + hstepA, voffA);
            PG8_WAIT_V(8); PG8_WAIT_L(0); PG8_BAR; PG8_MMA(0, 0, At, B0); PG8_MMA(0, 1, At, B1); PG8_BAR; PG8_SCHED;
            PG8_LDA(At, 1, 1); PG8_STAGE(PG8_SB(1, 0), b3, voffB); PG8_STAGE(PG8_SB(1, 1), b3 + hstepB, voffB); PG8_STAGE(PG8_SA(1, 0), a3, voffA);
            PG8_WAIT_V(8); PG8_WAIT_L(0); PG8_BAR; PG8_MMA(1, 0, At, B0); PG8_MMA(1, 1, At, B1); PG8_BAR; PG8_SCHED;
            } else {
            PG8_LDB(B0, 0, 0); PG8_SCHED; PG8_LDA(At, 0, 0); PG8_STAGE(PG8_SA(1, 1), a1 + hstepA, voffA);
            PG8_WAIT_L(8); PG8_BAR; PG8_WAIT_L(0); PG8_MMA(0, 0, At, B0); PG8_BAR; PG8_SCHED;
            PG8_LDB(B1, 0, 1); PG8_STAGE(PG8_SB(0, 0), b2, voffB);
            PG8_BAR; PG8_WAIT_L(0); PG8_MMA(0, 1, At, B1); PG8_BAR;
            PG8_LDA(At, 0, 1); PG8_STAGE(PG8_SA(0, 0), a2, voffA);
            PG8_BAR; PG8_WAIT_L(0); PG8_MMA(1, 0, At, B0); PG8_BAR; PG8_SCHED;
            PG8_STAGE(PG8_SB(0, 1), b2 + hstepB, voffB);
            PG8_WAIT_V(6); PG8_BAR; PG8_MMA(1, 1, At, B1); PG8_BAR;
            PG8_LDB(B0, 1, 0); PG8_SCHED; PG8_LDA(At, 1, 0); PG8_STAGE(PG8_SA(0, 1), a2 + hstepA, voffA);
            PG8_WAIT_L(8); PG8_BAR; PG8_WAIT_L(0); PG8_MMA(0, 0, At, B0); PG8_BAR; PG8_SCHED;
            PG8_LDB(B1, 1, 1); PG8_STAGE(PG8_SB(1, 0), b3, voffB);
            PG8_BAR; PG8_WAIT_L(0); PG8_MMA(0, 1, At, B1); PG8_BAR;
            PG8_LDA(At, 1, 1); PG8_STAGE(PG8_SA(1, 0), a3, voffA);
            PG8_BAR; PG8_WAIT_L(0); PG8_MMA(1, 0, At, B0); PG8_BAR; PG8_SCHED;
            PG8_STAGE(PG8_SB(1, 1), b3 + hstepB, voffB);
            PG8_WAIT_V(6); PG8_BAR; PG8_MMA(1, 1, At, B1); PG8_BAR;
            }
        }
        if constexpr (ALIGN_EPI) { if (wr == 0) PG8_BAR; }
        E(acc, cur, wr, wc, fr, fq);
        if (!has_next) break;
#pragma unroll
        for (int a = 0; a < 2; ++a)
#pragma unroll
            for (int b = 0; b < 2; ++b)
#pragma unroll
                for (int m = 0; m < 4; ++m)
#pragma unroll
                    for (int n = 0; n < 2; ++n) acc[a][b][m][n] = (f32x4){0.f, 0.f, 0.f, 0.f};
        cur = nxt; cA = nA; cB = nB; ++ui;
        if constexpr (ALIGN_EPI) { if (wr == 1) PG8_BAR; }
    }
    PG8_WAIT_V(0);
    if constexpr (!ALIGN_EPI) { if (wr == 0) PG8_BAR; }
    PG8_BAR;
#undef PG8_SA
#undef PG8_SB
#undef PG8_STAGE
#undef PG8_LDA
#undef PG8_LDB
#undef PG8_MMA
#undef PG8_WAIT_V
#undef PG8_WAIT_L
#undef PG8_BAR
#undef PG8_SCHED
#undef PG8_ATILE
}
}

typedef unsigned short bf16_t;
#define LAS __attribute__((address_space(3)))
constexpr int NT = 512;
constexpr int T_TOK = 32768, SEQ = 4096, NB = 8, DM = 1024, PLE = 256;
constexpr size_t MiB = (size_t)1 << 20;
constexpr size_t WS_U = 0, WS_PROJ = 64 * MiB, WS_T1 = WS_PROJ, WS_E = WS_PROJ + 128 * MiB, WS_YA = 320 * MiB, WS_YB = 384 * MiB,
                 WS_WIN = 448 * MiB, WS_WOUT = 464 * MiB, WS_PPROJ = 468 * MiB, WS_PGATE = 469 * MiB, WS_PB = 472 * MiB, WS_A3 = 488 * MiB, WS_CTL = 490 * MiB, WS_END = 491 * MiB;
constexpr int LDS_BYTES = 144 * 1024 + 16;
constexpr float RMS_EPS = 1e-6f;

struct Params { const float* in[22]; float* out; unsigned char* ws; int ph_lo, ph_hi; };

__device__ __forceinline__ int otid() { int t = threadIdx.x; asm volatile("" : "+v"(t)); return t; }
typedef unsigned ntu4_t __attribute__((ext_vector_type(4)));
typedef float ntf4_t __attribute__((ext_vector_type(4)));
__device__ __forceinline__ uint4 ntld_u4(const void* p) { const ntu4_t v = __builtin_nontemporal_load((const ntu4_t*)p); return make_uint4(v.x, v.y, v.z, v.w); }
__device__ __forceinline__ float4 ntld_f4(const void* p) { const ntf4_t v = __builtin_nontemporal_load((const ntf4_t*)p); return make_float4(v.x, v.y, v.z, v.w); }
__device__ __forceinline__ float bf2f(bf16_t b) { return __uint_as_float(((unsigned)b) << 16); }
__device__ __forceinline__ bf16_t f2bf(float f) { unsigned u = __float_as_uint(f); u += 0x7FFFu + ((u >> 16) & 1u); return (bf16_t)(u >> 16); }
__device__ __forceinline__ int olane() { int l = __builtin_amdgcn_mbcnt_hi(-1, __builtin_amdgcn_mbcnt_lo(-1, 0)); asm volatile("" : "+v"(l)); return l; }
__device__ __forceinline__ float bperm_f(int addr, float v) { return __uint_as_float((unsigned)__builtin_amdgcn_ds_bpermute(addr, (int)__float_as_uint(v))); }
__device__ __forceinline__ float wave_sum(float v) { const int l = olane();
#pragma unroll
    for (int o = 32; o >= 1; o >>= 1) v += bperm_f((l ^ o) << 2, v);
    return v; }
__device__ __forceinline__ float wave_max(float v) { const int l = olane();
#pragma unroll
    for (int o = 32; o >= 1; o >>= 1) v = fmaxf(v, bperm_f((l ^ o) << 2, v));
    return v; }
__device__ __forceinline__ float silu(float x) { return x * __builtin_amdgcn_rcpf(1.0f + __expf(-x)); }

__device__ void ph_rmsnorm_rows(const float* __restrict__ hin, const float* __restrict__ g, bf16_t* __restrict__ out) {
    const int tid = otid(); const int lane = tid & 63, wid = tid >> 6;
    for (int row = blockIdx.x * 8 + wid; row < T_TOK; row += gridDim.x * 8) {
        const float4* src = (const float4*)(hin + (size_t)row * DM);
        float4 v[4]; float ss = 0.f;
#pragma unroll
        for (int i = 0; i < 4; ++i) { v[i] = src[lane + 64 * i]; ss += v[i].x * v[i].x + v[i].y * v[i].y + v[i].z * v[i].z + v[i].w * v[i].w; }
        ss = wave_sum(ss);
        const float r = rsqrtf(ss * (1.0f / DM) + RMS_EPS);
#pragma unroll
        for (int i = 0; i < 4; ++i) { const float4 gv = ((const float4*)g)[lane + 64 * i];
            uint2 w; w.x = pg8::cvt_pk_bf16(v[i].x * r * gv.x, v[i].y * r * gv.y); w.y = pg8::cvt_pk_bf16(v[i].z * r * gv.z, v[i].w * r * gv.w);
            *(uint2*)(out + (size_t)row * DM + (lane + 64 * i) * 4) = w; }
    }
}
__device__ void ph_rmsnorm_rows_b16(const bf16_t* __restrict__ hb, const float* __restrict__ g, bf16_t* __restrict__ out) {
    const int tid = otid(); const int lane = tid & 63, wid = tid >> 6;
    const bool xaff = (gridDim.x == 256);
    const int row_first = xaff ? (((int)blockIdx.x & 7) << 12) + (((int)blockIdx.x >> 3) << 3) + wid : (int)blockIdx.x * 8 + wid;
    const int row_step = xaff ? 256 : (int)gridDim.x * 8, row_end = xaff ? ((((int)blockIdx.x & 7) + 1) << 12) : T_TOK;
    for (int row = row_first; row < row_end; row += row_step) {
        const size_t ro = (size_t)row * DM; uint4 w[2]; float v[2][8]; float ss = 0.f;
#pragma unroll
        for (int i = 0; i < 2; ++i) w[i] = ntld_u4(hb + ro + (lane + 64 * i) * 8);
#pragma unroll
        for (int i = 0; i < 2; ++i) { const unsigned ww[4] = {w[i].x, w[i].y, w[i].z, w[i].w};
#pragma unroll
            for (int k = 0; k < 4; ++k) { v[i][2 * k] = __uint_as_float(ww[k] << 16); v[i][2 * k + 1] = __uint_as_float(ww[k] & 0xffff0000u); ss += v[i][2 * k] * v[i][2 * k] + v[i][2 * k + 1] * v[i][2 * k + 1]; } }
        ss = wave_sum(ss);
        const float r = rsqrtf(ss * (1.0f / DM) + RMS_EPS);
        float4 gaa[2], gbb[2];
#pragma unroll
        for (int i = 0; i < 2; ++i) { const int e0 = (lane + 64 * i) * 8; gaa[i] = *(const float4*)(g + e0); gbb[i] = *(const float4*)(g + e0 + 4); }
#pragma unroll
        for (int i = 0; i < 2; ++i) { const int e0 = (lane + 64 * i) * 8; const float4 ga = gaa[i], gb = gbb[i];
            uint4 o; o.x = pg8::cvt_pk_bf16(v[i][0] * r * ga.x, v[i][1] * r * ga.y); o.y = pg8::cvt_pk_bf16(v[i][2] * r * ga.z, v[i][3] * r * ga.w);
            o.z = pg8::cvt_pk_bf16(v[i][4] * r * gb.x, v[i][5] * r * gb.y); o.w = pg8::cvt_pk_bf16(v[i][6] * r * gb.z, v[i][7] * r * gb.w);
            *(uint4*)(out + ro + e0) = o; }
    }
}
__device__ void prep_tile(const float* __restrict__ src, int srcld, bf16_t* __restrict__ dst, int K, int n0, int srccol0, int k0, float* sl) {
    const int tid = otid();
#pragma unroll
    for (int i = 0; i < 2; ++i) { const int idx = tid + NT * i, kk = idx >> 4, c4 = idx & 15;
        const float4 v = ntld_f4(src + (size_t)(k0 + kk) * srcld + srccol0 + c4 * 4);
        float* d = sl + kk * 65 + c4 * 4; d[0] = v.x; d[1] = v.y; d[2] = v.z; d[3] = v.w; }
    __syncthreads();
    { const int n = tid >> 3, kg = tid & 7; float f[8];
#pragma unroll
      for (int j = 0; j < 8; ++j) f[j] = sl[(kg * 8 + j) * 65 + n];
      uint4 w; w.x = pg8::cvt_pk_bf16(f[0], f[1]); w.y = pg8::cvt_pk_bf16(f[2], f[3]); w.z = pg8::cvt_pk_bf16(f[4], f[5]); w.w = pg8::cvt_pk_bf16(f[6], f[7]);
      *(uint4*)(dst + (size_t)(n0 + n) * K + k0 + kg * 8) = w; }
    __syncthreads();
}
__device__ void ph_prep_weights(const Params& P, int layer, float* sl) {
    unsigned char* ws = P.ws;
    const bool odd = (layer & 1);
    for (int t = blockIdx.x; t < 2880; t += gridDim.x) {
        if (t < 2048) { const int nt_ = t >> 4, kt = t & 15, n0 = nt_ * 64; int sc = n0;
            if (odd) { const int half = n0 >> 12, j = n0 & 4095; sc = (j >> 10) * 2048 + half * 1024 + (j & 1023); }
            prep_tile(P.in[2] + (size_t)layer * 1024 * 8192, 8192, (bf16_t*)(ws + WS_WIN), 1024, n0, sc, kt * 64, sl); }
        else if (t < 2560) { const int q = t - 2048, nt_ = q >> 5, kt = q & 31;
            prep_tile(P.in[3] + (size_t)layer * 2048 * 1024, 1024, (bf16_t*)(ws + WS_WOUT), 2048, nt_ * 64, nt_ * 64, kt * 64, sl); }
        else if (t < 2624) { const int q = t - 2560, nt_ = q >> 2, kt = q & 3;
            prep_tile(P.in[19] + (size_t)layer * 256 * 1024, 1024, (bf16_t*)(ws + WS_PPROJ), 256, nt_ * 64, nt_ * 64, kt * 64, sl); }
        else { const int q = t - 2624, nt_ = q >> 4, kt = q & 15;
            prep_tile(P.in[21] + (size_t)layer * 1024 * 1024, 1024, (bf16_t*)(ws + WS_PGATE), 1024, nt_ * 64, nt_ * 64, kt * 64, sl); }
    }
}
__device__ void ph_convert_p(const float* __restrict__ p, bf16_t* __restrict__ pb) {
    const size_t n4 = (size_t)T_TOK * PLE / 4;
    for (size_t i = (size_t)blockIdx.x * NT + otid(); i < n4; i += (size_t)gridDim.x * NT) {
        const float4 v = ntld_f4(((const float4*)p) + i); uint2 w; w.x = pg8::cvt_pk_bf16(v.x, v.y); w.y = pg8::cvt_pk_bf16(v.z, v.w); ((uint2*)pb)[i] = w; }
}
__device__ void ph_filter_mlp(const Params& P, int j, float* __restrict__ a3) {
    const int tid = otid(); const int lane = tid & 63, wid = tid >> 6;
    const float* w1 = P.in[8] + (size_t)j * 33 * 64; const float* b1 = P.in[9] + j * 64;
    const float* w2 = P.in[10] + (size_t)j * 64 * 64; const float* b2 = P.in[11] + j * 64;
    const float* w3 = P.in[12] + (size_t)j * 64 * 64; const float* b3 = P.in[13] + j * 64;
    const float fq = P.in[15][j * 64 + lane];
    for (int pos = blockIdx.x * 8 + wid; pos < SEQ; pos += gridDim.x * 8) {
        float z = 0.f;
        const float wpos = (float)(2.0 * 3.14159265358979323846 / SEQ) * (float)pos;
        if (lane == 0) z = (float)pos / (float)(SEQ - 1);
        else if (lane <= 16) { const float fr = 1e-4f + (float)(lane - 1) * ((15.0f - 1e-4f) / 15.0f); z = cosf(fr * wpos); }
        else if (lane <= 32) { const float fr = 1e-4f + (float)(lane - 17) * ((15.0f - 1e-4f) / 15.0f); z = -sinf(fr * wpos); }
        float acc = b1[lane];
        for (int i = 0; i < 33; ++i) acc += __shfl(z, i) * w1[i * 64 + lane];
        float a = sinf(fq * acc);
        acc = b2[lane];
        for (int i = 0; i < 64; ++i) acc += __shfl(a, i) * w2[i * 64 + lane];
        a = sinf(fq * acc);
        acc = b3[lane];
        for (int i = 0; i < 64; ++i) acc += __shfl(a, i) * w3[i * 64 + lane];
        a = sinf(fq * acc);
        a3[pos * 64 + lane] = a;
    }
}
__device__ void ph_filter_gen(const Params& P, int j, const float* __restrict__ a3, float* __restrict__ kf, float* sl) {
    const int tid = otid(), lane = tid & 63, wid = tid >> 6;
    const float* w4 = P.in[14] + (size_t)j * 64 * 4096;
    float* sw = sl; float* red = sl + 256;
    const float min_decay = logf(1e-2f) / 1.5f, max_decay = logf(1e-2f) / 0.3f;
    for (int c = blockIdx.x; c < 1024; c += gridDim.x) {
        if (tid < 256) { const int jj = tid >> 2, q = tid & 3; sw[tid] = w4[(size_t)jj * 4096 + q * 1024 + c]; }
        __syncthreads();
        const float delta = fabsf(min_decay + (float)c * ((max_decay - min_decay) / 1023.0f));
        float hv[8][4]; float n0 = 0.f, n1 = 0.f;
#pragma unroll
        for (int i = 0; i < 8; ++i) { const int t = tid + NT * i; const float4* ar = (const float4*)(a3 + (size_t)t * 64);
            float a0 = 0.f, a1 = 0.f, a2 = 0.f, a3v = 0.f;
#pragma unroll 4
            for (int jq = 0; jq < 16; ++jq) { const float4 av = ar[jq]; const float ae[4] = {av.x, av.y, av.z, av.w};
#pragma unroll
                for (int e = 0; e < 4; ++e) { const float4 wv = *(const float4*)(sw + (jq * 4 + e) * 4); a0 += ae[e] * wv.x; a1 += ae[e] * wv.y; a2 += ae[e] * wv.z; a3v += ae[e] * wv.w; } }
            const float dec = expf(-((float)t / (float)(SEQ - 1)) * delta);
            hv[i][0] = a0 * dec; hv[i][1] = a1 * dec; hv[i][2] = a2 * dec; hv[i][3] = a3v * dec;
            n0 += fabsf(hv[i][0]) + (t >= 1 ? fabsf(hv[i][1]) : 0.f); n1 += fabsf(hv[i][2]) + (t >= 1 ? fabsf(hv[i][3]) : 0.f); }
        n0 = wave_sum(n0); n1 = wave_sum(n1);
        if (lane == 0) { red[wid * 2] = n0; red[wid * 2 + 1] = n1; }
        __syncthreads();
        float s0 = 0.f, s1 = 0.f;
#pragma unroll
        for (int w = 0; w < 8; ++w) { s0 += red[w * 2]; s1 += red[w * 2 + 1]; }
        const float i0 = 1.0f / s0, i1 = 1.0f / s1;
        float* k0 = kf + (size_t)c * 8192; float* k1 = kf + (size_t)(1024 + c) * 8192;
#pragma unroll
        for (int i = 0; i < 8; ++i) { const int t = tid + NT * i;
            k0[t] = hv[i][0] * i0; k1[t] = hv[i][2] * i1;
            if (t >= 1) { k0[8192 - t] = hv[i][1] * i0; k1[8192 - t] = hv[i][3] * i1; } }
        if (tid == 0) { k0[4096] = 0.f; k1[4096] = 0.f; }
        __syncthreads();
    }
}

__device__ __forceinline__ float sconv(const bf16_t* row, int t, float w0, float w1, float w2, float b) {
    const float xm = t > 0 ? bf2f(row[t - 1]) : 0.f, x0 = bf2f(row[t]), xp = t < SEQ - 1 ? bf2f(row[t + 1]) : 0.f;
    return w0 * xm + w1 * x0 + w2 * xp + b; }
__device__ void ph_hyena_naive(const Params& P, int j, const bf16_t* __restrict__ projAT, const float* __restrict__ kf, bf16_t* __restrict__ yaT, float* sl) {
    const int tid = otid();
    float* sv = sl; float* sk = sl + 4096; float* sz = sk + 8192;
    const float* cw = P.in[6] + (size_t)j * 3 * 3072; const float* cb = P.in[7] + (size_t)j * 3072; const float* skip = P.in[16] + (size_t)j * 2 * 1024;
    for (int unit = blockIdx.x; unit < 8192; unit += gridDim.x) {
        const int c = unit >> 3, b = unit & 7;
        const bf16_t* vrow = projAT + (size_t)c * T_TOK + b * SEQ; const bf16_t* x1row = projAT + (size_t)(1024 + c) * T_TOK + b * SEQ;
        const bf16_t* x2row = projAT + (size_t)(2048 + c) * T_TOK + b * SEQ; const bf16_t* grow = projAT + (size_t)(3072 + c) * T_TOK + b * SEQ;
        const float wv0 = cw[c], wv1 = cw[3072 + c], wv2 = cw[6144 + c], bv = cb[c];
        const float wa0 = cw[1024 + c], wa1 = cw[3072 + 1024 + c], wa2 = cw[6144 + 1024 + c], ba = cb[1024 + c];
        const float wb0 = cw[2048 + c], wb1 = cw[3072 + 2048 + c], wb2 = cw[6144 + 2048 + c], bb = cb[2048 + c];
        const float sk0 = skip[c], sk1 = skip[1024 + c];
        for (int t = tid; t < SEQ; t += NT) sv[t] = sconv(vrow, t, wv0, wv1, wv2, bv);
        for (int i = tid; i < 8192; i += NT) sk[i] = kf[(size_t)c * 8192 + i];
        __syncthreads();
        float acc[8];
#pragma unroll
        for (int i = 0; i < 8; ++i) acc[i] = 0.f;
        for (int s = 0; s < SEQ; ++s) { const float vs = sv[s];
#pragma unroll
            for (int i = 0; i < 8; ++i) acc[i] += vs * sk[(tid + NT * i - s) & 8191]; }
#pragma unroll
        for (int i = 0; i < 8; ++i) { const int t = tid + NT * i; sz[t] = sconv(x1row, t, wa0, wa1, wa2, ba) * (acc[i] + sk0 * sv[t]); }
        __syncthreads();
        for (int i = tid; i < 8192; i += NT) sk[i] = kf[(size_t)(1024 + c) * 8192 + i];
        __syncthreads();
#pragma unroll
        for (int i = 0; i < 8; ++i) acc[i] = 0.f;
        for (int s = 0; s < SEQ; ++s) { const float vs = sz[s];
#pragma unroll
            for (int i = 0; i < 8; ++i) acc[i] += vs * sk[(tid + NT * i - s) & 8191]; }
#pragma unroll
        for (int i = 0; i < 8; ++i) { const int t = tid + NT * i;
            const float y = sconv(x2row, t, wb0, wb1, wb2, bb) * (acc[i] + sk1 * sz[t]) * silu(bf2f(grow[t]));
            yaT[(size_t)c * T_TOK + b * SEQ + t] = f2bf(y); }
        __syncthreads();
    }
}

struct cf { float x, y; };
__device__ __forceinline__ cf cmul(cf a, cf b) { return cf{a.x * b.x - a.y * b.y, a.x * b.y + a.y * b.x}; }
__device__ __forceinline__ cf cmulc(cf a, cf b) { return cf{a.x * b.x + a.y * b.y, a.y * b.x - a.x * b.y}; }
__device__ __forceinline__ constexpr float c16(int k) { constexpr float t[8] = {1.0f, 0.92387953251128674f, 0.70710678118654752f, 0.38268343236508977f, 0.0f, -0.38268343236508977f, -0.70710678118654752f, -0.92387953251128674f}; return t[k]; }
__device__ __forceinline__ constexpr float s16(int k) { constexpr float t[8] = {0.0f, 0.38268343236508977f, 0.70710678118654752f, 0.92387953251128674f, 1.0f, 0.92387953251128674f, 0.70710678118654752f, 0.38268343236508977f}; return t[k]; }
__device__ __forceinline__ cf twc(cf ws, int k16) { if (k16 == 0) return ws; if (k16 == 4) return cf{ws.y, -ws.x}; return cmul(ws, cf{c16(k16), -s16(k16)}); }
template <int LR> __device__ __forceinline__ void dif_reg(cf (&x)[1 << LR], cf w) {
    constexpr int R = 1 << LR; cf ws = w;
#pragma unroll
    for (int s = 0; s < LR; ++s) { const int half = R >> (s + 1);
#pragma unroll
        for (int m0 = 0; m0 < R; m0 += 2 * half)
#pragma unroll
            for (int mm = 0; mm < half; ++mm) { const int ia = m0 + mm, ib = ia + half; const cf a = x[ia], b = x[ib];
                x[ia] = cf{a.x + b.x, a.y + b.y}; const cf d{a.x - b.x, a.y - b.y};
                x[ib] = cmul(d, twc(ws, (mm << s) * (16 / R))); }
        ws = cmul(ws, ws); }
}
template <int LR> __device__ __forceinline__ void dit_reg(cf (&x)[1 << LR], cf w) {
    constexpr int R = 1 << LR; cf wsv[LR]; wsv[0] = w;
#pragma unroll
    for (int s = 1; s < LR; ++s) wsv[s] = cmul(wsv[s - 1], wsv[s - 1]);
#pragma unroll
    for (int s = LR - 1; s >= 0; --s) { const int half = R >> (s + 1);
#pragma unroll
        for (int m0 = 0; m0 < R; m0 += 2 * half)
#pragma unroll
            for (int mm = 0; mm < half; ++mm) { const int ia = m0 + mm, ib = ia + half; const cf a = x[ia];
                const cf b = cmulc(x[ib], twc(wsv[s], (mm << s) * (16 / R)));
                x[ia] = cf{a.x + b.x, a.y + b.y}; x[ib] = cf{a.x - b.x, a.y - b.y}; } }
}
typedef float v2f __attribute__((ext_vector_type(2)));
__device__ __forceinline__ v2f mkv2(float a, float b) { v2f r; r.x = a; r.y = b; return r; }
typedef LAS v2f* ldsf2;
__device__ __forceinline__ void lds_barrier() { asm volatile("s_waitcnt lgkmcnt(0)\n\ts_barrier" ::: "memory"); }
template <int LR, bool INV> __device__ __forceinline__ void fft_pass(ldsf2 buf, int base, int stride, int twi) {
    constexpr int R = 1 << LR; cf x[R];
    const v2f wv = ((ldsf2)((LAS unsigned char*)buf + 139264))[twi];
#pragma unroll
    for (int m = 0; m < R; ++m) { const v2f v = buf[base + m * stride]; x[m] = cf{v.x, v.y}; }
    const cf w{wv.x, wv.y};
    if (INV) dit_reg<LR>(x, w); else dif_reg<LR>(x, w);
#pragma unroll
    for (int m = 0; m < R; ++m) buf[base + m * stride] = mkv2(x[m].x, x[m].y);
}
__device__ __forceinline__ void wave_lds_fence() { asm volatile("s_waitcnt lgkmcnt(0)" ::: "memory"); }
__device__ __forceinline__ void fft_fwd_abc(ldsf2 buf) {
    const int tid = otid(); const int wv = tid >> 6, l = tid & 63;
#pragma unroll 1
    for (int u = 0; u < 2; ++u) { const int bf = tid + NT * u; fft_pass<3, false>(buf, bf + (bf >> 4), 1088, bf); }
    lds_barrier();
#pragma unroll 1
    for (int u = 0; u < 2; ++u) { const int o = l + 64 * u, e0 = wv * 1024 + o; fft_pass<3, false>(buf, e0 + (e0 >> 4), 136, o * 8); }
    wave_lds_fence();
#pragma unroll 1
    for (int u = 0; u < 2; ++u) { const int j = l + 64 * u, o = j & 15, e0 = wv * 1024 + (j >> 4) * 128 + o; fft_pass<3, false>(buf, e0 + (e0 >> 4), 17, o * 64); }
    wave_lds_fence();
}
__device__ __forceinline__ void fft_inv_cba(ldsf2 buf) {
    const int tid = otid(); const int wv = tid >> 6, l = tid & 63;
#pragma unroll 1
    for (int u = 0; u < 2; ++u) { const int j = l + 64 * u, o = j & 15, e0 = wv * 1024 + (j >> 4) * 128 + o; fft_pass<3, true>(buf, e0 + (e0 >> 4), 17, o * 64); }
    wave_lds_fence();
#pragma unroll 1
    for (int u = 0; u < 2; ++u) { const int o = l + 64 * u, e0 = wv * 1024 + o; fft_pass<3, true>(buf, e0 + (e0 >> 4), 136, o * 8); }
    lds_barrier();
#pragma unroll 1
    for (int u = 0; u < 2; ++u) { const int bf = tid + NT * u; fft_pass<3, true>(buf, bf + (bf >> 4), 1088, bf); }
    lds_barrier();
}
typedef _Float16 h2_t __attribute__((ext_vector_type(2)));
__device__ __forceinline__ void make_spec(ldsf2 buf, LAS unsigned* spec, const float* __restrict__ kfrow) {
    const int tid = otid();
#pragma unroll
    for (int q = 0; q < 4; ++q) { const float4 v = *(const float4*)(kfrow + tid * 16 + q * 4);
        buf[tid * 17 + q * 4 + 0] = mkv2(v.x, 0.f); buf[tid * 17 + q * 4 + 1] = mkv2(v.y, 0.f); buf[tid * 17 + q * 4 + 2] = mkv2(v.z, 0.f); buf[tid * 17 + q * 4 + 3] = mkv2(v.w, 0.f); }
    __syncthreads();
    fft_fwd_abc(buf);
    cf x[16];
#pragma unroll
    for (int m = 0; m < 16; ++m) { const v2f v = buf[tid * 17 + m]; x[m] = cf{v.x, v.y}; }
    dif_reg<4>(x, cf{1.0f, 0.0f});
#pragma unroll
    for (int m = 0; m < 16; ++m) { h2_t hv; hv.x = (_Float16)x[m].x; hv.y = (_Float16)x[m].y; spec[tid * 17 + m] = __builtin_bit_cast(unsigned, hv); }
    lds_barrier();
}
__device__ __forceinline__ void fft_conv(ldsf2 buf, const LAS unsigned* spec) {
    fft_fwd_abc(buf);
    { const int tid = otid(); cf x[16];
#pragma unroll
      for (int m = 0; m < 16; ++m) { const v2f v = buf[tid * 17 + m]; x[m] = cf{v.x, v.y}; }
      dif_reg<4>(x, cf{1.0f, 0.0f});
#pragma unroll
      for (int m = 0; m < 16; ++m) { const h2_t hv = __builtin_bit_cast(h2_t, spec[tid * 17 + m]); x[m] = cmul(x[m], cf{(float)hv.x, (float)hv.y}); }
      dit_reg<4>(x, cf{1.0f, 0.0f});
#pragma unroll
      for (int m = 0; m < 16; ++m) buf[tid * 17 + m] = mkv2(x[m].x, x[m].y); }
    wave_lds_fence();
    fft_inv_cba(buf);
}
struct Raw8 { uint4 body; unsigned short eL, eR; };
__device__ __forceinline__ Raw8 load_raw8(const bf16_t* __restrict__ row, int n0) {
    Raw8 r; r.body = ntld_u4(row + n0); r.eL = row[n0 > 0 ? n0 - 1 : 0]; r.eR = row[n0 + 8 < SEQ ? n0 + 8 : SEQ - 1]; return r; }
__device__ __forceinline__ void sconv8(const Raw8& r, int n0, float w0, float w1, float w2, float b, float (&out)[8]) {
    float a[10]; a[0] = n0 > 0 ? bf2f(r.eL) : 0.f; a[9] = n0 + 8 < SEQ ? bf2f(r.eR) : 0.f;
    a[1] = __uint_as_float(r.body.x << 16); a[2] = __uint_as_float(r.body.x & 0xffff0000u); a[3] = __uint_as_float(r.body.y << 16); a[4] = __uint_as_float(r.body.y & 0xffff0000u);
    a[5] = __uint_as_float(r.body.z << 16); a[6] = __uint_as_float(r.body.z & 0xffff0000u); a[7] = __uint_as_float(r.body.w << 16); a[8] = __uint_as_float(r.body.w & 0xffff0000u);
#pragma unroll
    for (int k = 0; k < 8; ++k) out[k] = w0 * a[k] + w1 * a[k + 1] + w2 * a[k + 2] + b;
}
__device__ void ph_hyena_fft(const Params& P, int j, const bf16_t* __restrict__ projAT, const float* __restrict__ kf, bf16_t* __restrict__ yaT, unsigned char* lds_raw) {
    const int tid = otid();
    ldsf2 buf = (ldsf2)lds_raw; LAS unsigned* spec1 = (LAS unsigned*)(lds_raw + 69632); LAS unsigned* spec2 = spec1 + 8704;
    const float* cw = P.in[6] + (size_t)j * 3 * 3072; const float* cb = P.in[7] + (size_t)j * 3072; const float* skip = P.in[16] + (size_t)j * 2 * 1024;
    const float invN = 1.0f / 8192.0f;
    const int n0 = tid * 8, ph0 = n0 + (n0 >> 4);
    { ldsf2 twt = (ldsf2)((LAS unsigned char*)buf + 139264);
      for (int k = tid; k < 1024; k += NT) { float sn, cs; sincospif((float)k * (2.0f / 8192.0f), &sn, &cs); twt[k] = mkv2(cs, -sn); }
      __syncthreads(); }
#pragma unroll 1
    for (int c = blockIdx.x; c < 1024; c += gridDim.x) {
        make_spec(buf, spec1, kf + (size_t)c * 8192);
        make_spec(buf, spec2, kf + (size_t)(1024 + c) * 8192);
        const float wv0 = cw[c], wv1 = cw[3072 + c], wv2 = cw[6144 + c], bv = cb[c];
        const float wa0 = cw[1024 + c], wa1 = cw[3072 + 1024 + c], wa2 = cw[6144 + 1024 + c], ba = cb[1024 + c];
        const float wb0 = cw[2048 + c], wb1 = cw[3072 + 2048 + c], wb2 = cw[6144 + 2048 + c], bb = cb[2048 + c];
        const float sk0 = skip[c], sk1 = skip[1024 + c];
        const bf16_t* vrow = projAT + (size_t)c * T_TOK; const bf16_t* x1row = projAT + (size_t)(1024 + c) * T_TOK;
        const bf16_t* x2row = projAT + (size_t)(2048 + c) * T_TOK; const bf16_t* grow = projAT + (size_t)(3072 + c) * T_TOK;
#pragma unroll 1
        for (int bp = 0; bp < 4; ++bp) {
            const size_t o0 = (size_t)(2 * bp) * SEQ, o1 = o0 + SEQ;
            float va[8], vb[8];
            { const Raw8 r0 = load_raw8(vrow + o0, n0), r1 = load_raw8(vrow + o1, n0); sconv8(r0, n0, wv0, wv1, wv2, bv, va); sconv8(r1, n0, wv0, wv1, wv2, bv, vb); }
#pragma unroll
            for (int k = 0; k < 8; ++k) { buf[ph0 + k] = mkv2(va[k], vb[k]); buf[ph0 + 4352 + k] = mkv2(0.f, 0.f); }
            const Raw8 xa0 = load_raw8(x1row + o0, n0), xa1 = load_raw8(x1row + o1, n0);
            lds_barrier();
            fft_conv(buf, spec1);
            { float xa[8], xb[8]; sconv8(xa0, n0, wa0, wa1, wa2, ba, xa); sconv8(xa1, n0, wa0, wa1, wa2, ba, xb);
#pragma unroll
              for (int k = 0; k < 8; ++k) { const v2f y = buf[ph0 + k]; va[k] = xa[k] * (y.x * invN + sk0 * va[k]); vb[k] = xb[k] * (y.y * invN + sk0 * vb[k]);
                  buf[ph0 + k] = mkv2(va[k], vb[k]); buf[ph0 + 4352 + k] = mkv2(0.f, 0.f); } }
            const Raw8 xb0 = load_raw8(x2row + o0, n0), xb1 = load_raw8(x2row + o1, n0);
            const uint4 g0 = ntld_u4(grow + o0 + n0), g1 = ntld_u4(grow + o1 + n0);
            lds_barrier();
            fft_conv(buf, spec2);
            { float xa[8], xb[8]; sconv8(xb0, n0, wb0, wb1, wb2, bb, xa); sconv8(xb1, n0, wb0, wb1, wb2, bb, xb);
              const unsigned gw0[4] = {g0.x, g0.y, g0.z, g0.w}, gw1[4] = {g1.x, g1.y, g1.z, g1.w}; unsigned w0[4], w1[4];
#pragma unroll
              for (int k2 = 0; k2 < 4; ++k2) { const v2f ya = buf[ph0 + 2 * k2], yb = buf[ph0 + 2 * k2 + 1];
                  const float ra = xa[2 * k2] * (ya.x * invN + sk1 * va[2 * k2]) * silu(__uint_as_float(gw0[k2] << 16));
                  const float rb = xa[2 * k2 + 1] * (yb.x * invN + sk1 * va[2 * k2 + 1]) * silu(__uint_as_float(gw0[k2] & 0xffff0000u));
                  const float rc = xb[2 * k2] * (ya.y * invN + sk1 * vb[2 * k2]) * silu(__uint_as_float(gw1[k2] << 16));
                  const float rd = xb[2 * k2 + 1] * (yb.y * invN + sk1 * vb[2 * k2 + 1]) * silu(__uint_as_float(gw1[k2] & 0xffff0000u));
                  w0[k2] = (unsigned)f2bf(ra) | ((unsigned)f2bf(rb) << 16); w1[k2] = (unsigned)f2bf(rc) | ((unsigned)f2bf(rd) << 16); }
              *(uint4*)(yaT + (size_t)c * T_TOK + o0 + n0) = make_uint4(w0[0], w0[1], w0[2], w0[3]);
              *(uint4*)(yaT + (size_t)c * T_TOK + o1 + n0) = make_uint4(w1[0], w1[1], w1[2], w1[3]); }
            lds_barrier();
        }
    }
}
__device__ void ph_transpose_ya(const bf16_t* __restrict__ yaT, bf16_t* __restrict__ yA, bf16_t* sl) {
    const int tid = otid();
    const int cc = tid >> 3, t8 = tid & 7;
    int tile = blockIdx.x; if (tile >= 16 * 512) return;
    uint4 v = ntld_u4(yaT + (size_t)((tile & 15) * 64 + cc) * T_TOK + (tile >> 4) * 64 + t8 * 8);
    for (;;) {
        const int c0 = (tile & 15) * 64, t0 = (tile >> 4) * 64;
        { const bf16_t* e = (const bf16_t*)&v;
#pragma unroll
          for (int jx = 0; jx < 8; ++jx) sl[cc * 66 + t8 * 8 + jx] = e[jx]; }
        __syncthreads();
        const int tn = tile + gridDim.x; const bool more = tn < 16 * 512;
        if (more) v = ntld_u4(yaT + (size_t)((tn & 15) * 64 + cc) * T_TOK + (tn >> 4) * 64 + t8 * 8);
        { const int tt = tid >> 3, c8 = tid & 7; unsigned w[4];
#pragma unroll
          for (int jx = 0; jx < 4; ++jx) w[jx] = (unsigned)sl[(c8 * 8 + 2 * jx) * 66 + tt] | ((unsigned)sl[(c8 * 8 + 2 * jx + 1) * 66 + tt] << 16);
          *(uint4*)(yA + (size_t)(t0 + tt) * DM + c0 + c8 * 8) = make_uint4(w[0], w[1], w[2], w[3]); }
        asm volatile("s_waitcnt lgkmcnt(0)\n\ts_barrier" ::: "memory");
        if (!more) break;
        tile = tn;
    }
}

__device__ __forceinline__ float dot8(const uint4& a, const uint4& b) {
    float d = 0.f;
    const unsigned aw[4] = {a.x, a.y, a.z, a.w}, bw[4] = {b.x, b.y, b.z, b.w};
#pragma unroll
    for (int i = 0; i < 4; ++i) { d += __uint_as_float(aw[i] << 16) * __uint_as_float(bw[i] << 16); d += __uint_as_float(aw[i] & 0xffff0000u) * __uint_as_float(bw[i] & 0xffff0000u); }
    return d; }
__device__ __forceinline__ int t5_bucket(int rel) {
    const int n = rel < 0 ? -rel : rel; const int ret = rel > 0 ? 16 : 0;
    int large = 8 + (int)(logf((float)(n < 1 ? 1 : n) / 8.0f) / logf(128.0f) * 8.0f); large = large > 15 ? 15 : large;
    return ret + (n < 8 ? n : large); }

template <int NSLOT, class F>
__device__ __forceinline__ void naive_attn_one(const bf16_t* __restrict__ proj, int tq, int h, const F& f, bf16_t* __restrict__ yout, int lane) {
    const uint4* qp = (const uint4*)(proj + (size_t)tq * 4096 + h * 64);
    uint4 q[8];
#pragma unroll
    for (int i = 0; i < 8; ++i) q[i] = qp[i];
    float s[NSLOT]; int tk[NSLOT]; float mx = -1e30f;
#pragma unroll
    for (int e = 0; e < NSLOT; ++e) { int tok; float bias; f(e, lane, tok, bias); tk[e] = tok; s[e] = -1e30f;
        if (tok >= 0) { const uint4* kp = (const uint4*)(proj + (size_t)tok * 4096 + 1024 + h * 64); float d = 0.f;
#pragma unroll
            for (int i = 0; i < 8; ++i) d += dot8(q[i], kp[i]);
            s[e] = d * 0.125f + bias; }
        mx = fmaxf(mx, s[e]); }
    mx = wave_max(mx);
    float sum = 0.f;
#pragma unroll
    for (int e = 0; e < NSLOT; ++e) { const float p = tk[e] >= 0 ? __expf(s[e] - mx) : 0.f; s[e] = p; sum += p; }
    sum = wave_sum(sum);
    float o = 0.f;
#pragma unroll
    for (int e = 0; e < NSLOT; ++e) {
        for (int l = 0; l < 64; ++l) { const int t2 = __builtin_amdgcn_readlane(tk[e], l); const float p = __uint_as_float((unsigned)__builtin_amdgcn_readlane((int)__float_as_uint(s[e]), l));
            if (t2 >= 0) o += p * bf2f(proj[(size_t)t2 * 4096 + 2048 + h * 64 + lane]); } }
    o /= sum;
    const float gate = bf2f(proj[(size_t)tq * 4096 + 3072 + h * 64 + lane]);
    yout[(size_t)tq * 1024 + h * 64 + lane] = f2bf(o * silu(gate));
}
struct DilF { int t; int b; int h; const float* rel_bias;
    __device__ __forceinline__ void operator()(int e, int lane, int& tok, float& bias) const {
        const int pi = e / 3, jj = (e % 3) * 64 + lane; const int r = pi == 0 ? 1 : (pi == 1 ? 4 : 16);
        const int rel = (jj - 64) * r, tkk = t + rel;
        if (jj > 128 || tkk < 0 || tkk >= SEQ) { tok = -1; bias = 0.f; return; }
        tok = b * SEQ + tkk; bias = rel_bias[t5_bucket(rel) * 16 + h]; } };
struct NatF { int r, c, b; const float* rpb_h;
    __device__ __forceinline__ void operator()(int e, int lane, int& tok, float& bias) const {
        const int kk = e * 64 + lane, kr = kk >> 4, kc = kk & 15;
        int rs = r - 4; rs = rs < 0 ? 0 : (rs > 56 ? 56 : rs); int cs = c - 8; cs = cs < 0 ? 0 : (cs > 48 ? 48 : cs);
        tok = b * SEQ + (rs + kr) * 64 + cs + kc; bias = rpb_h[(rs + kr - r + 7) * 31 + (cs + kc - c + 15)]; } };
__device__ void ph_dilated_naive(const Params& P, const bf16_t* __restrict__ proj, bf16_t* __restrict__ yout) {
    const int tid = otid(); const int lane = tid & 63, wid = tid >> 6;
    for (int u = blockIdx.x * 8 + wid; u < T_TOK * 16; u += gridDim.x * 8) {
        const int h = u & 15, tq = u >> 4; DilF f{tq & (SEQ - 1), tq >> 12, h, P.in[17]};
        naive_attn_one<9, DilF>(proj, tq, h, f, yout, lane); }
}
__device__ void ph_natten_naive(const Params& P, int j, int half, const bf16_t* __restrict__ proj, bf16_t* __restrict__ yout) {
    const int tid = otid(); const int lane = tid & 63, wid = tid >> 6;
    const float* rpb = P.in[18] + (size_t)j * 32 * 15 * 31;
    for (int u = blockIdx.x * 8 + wid; u < T_TOK * 16; u += gridDim.x * 8) {
        const int h = u & 15, tq = u >> 4, pos = tq & (SEQ - 1); NatF f{pos >> 6, pos & 63, tq >> 12, rpb + (size_t)(half * 16 + h) * 15 * 31};
        naive_attn_one<2, NatF>(proj, tq, h, f, yout, lane); }
}


typedef float f32x16 __attribute__((ext_vector_type(16)));
typedef float f32x8v __attribute__((ext_vector_type(8)));
typedef __bf16 bf16x8n __attribute__((ext_vector_type(8)));
typedef short bf16x8s __attribute__((ext_vector_type(8)));
typedef unsigned u32x4a __attribute__((ext_vector_type(4)));
__device__ __forceinline__ int crow32(int reg, int h) { return (reg & 3) + 8 * (reg >> 2) + 4 * h; }
template <class Pol>
__device__ __forceinline__ void attn_loadk(const bf16_t* __restrict__ kbase, const Pol& pol, int fb, int r, int hh, bf16x8s (&kf)[4]) {
    const int ktr = pol.ktok(fb, r);
#pragma unroll
    for (int s = 0; s < 4; ++s) kf[s] = *(const bf16x8s*)(kbase + ktr * 64 + 16 * s + 8 * hh);
}
template <class Pol>
__device__ __forceinline__ void attn_loadv(const bf16_t* __restrict__ vbase, const Pol& pol, int fb, int r, int hh, u32x4a (&vg)[4]) {
    const int lane = hh * 32 + r;
#pragma unroll
    for (int j = 0; j < 4; ++j) { const int vt = pol.ktok(fb, 8 * j + (lane >> 3)); vg[j] = *(const u32x4a*)(vbase + vt * 64 + (lane & 7) * 8); }
}
template <class Pol>
__device__ __forceinline__ void attn_compute(const bf16_t* __restrict__ kbase, const Pol& pol, int fb, int fbn, bool first, int r, int hh, int xaddr, const bf16x8s (&qf)[4], bf16x8s (&kf)[4], u32x4a (&vg)[4], const bf16_t* __restrict__ vbase, LAS unsigned char* wl,
                                             f32x16& o0, f32x16& o1, float& m_run, float& l_run) {
    f32x16 sc;
#pragma unroll
    for (int i = 0; i < 16; ++i) sc[i] = 0.f;
#pragma unroll
    for (int s = 0; s < 4; ++s) sc = __builtin_amdgcn_mfma_f32_32x32x16_bf16(kf[s], qf[s], sc, 0, 0, 0);
    attn_loadk<Pol>(kbase, pol, fbn, r, hh, kf);
    pol.scores(fb, r, hh, sc);
    if (first) { float bm = sc[0];
#pragma unroll
        for (int i = 1; i < 16; ++i) bm = fmaxf(bm, sc[i]);
        bm = fmaxf(bm, bperm_f(xaddr, bm)); m_run = fmaxf(bm, -40.0f); }
    float psum = 0.f;
#pragma unroll
    for (int i = 0; i < 16; ++i) { const float p = __builtin_amdgcn_exp2f(sc[i] - m_run); sc[i] = p; psum += p; }
    l_run += psum;
    { const int lane = hh * 32 + r;
      asm volatile("" ::: "memory");
#pragma unroll
      for (int j = 0; j < 4; ++j) *(LAS u32x4a*)(wl + (8 * j + (lane >> 3)) * 144 + (lane & 7) * 16) = vg[j];
      asm volatile("" ::: "memory"); }
    attn_loadv<Pol>(vbase, pol, fbn, r, hh, vg);
    u32x4a va[2], vb[2];
    { const LAS unsigned short* rp = (const LAS unsigned short*)(wl + (4 * hh) * 144 + r * 2);
#pragma unroll
      for (int s = 0; s < 2; ++s)
#pragma unroll
        for (int jx = 0; jx < 4; ++jx) { const int k0 = 16 * s + 8 * ((2 * jx) >> 2) + ((2 * jx) & 3), k1 = k0 + 1;
            va[s][jx] = (unsigned)rp[k0 * 72] | ((unsigned)rp[k1 * 72] << 16); vb[s][jx] = (unsigned)rp[k0 * 72 + 32] | ((unsigned)rp[k1 * 72 + 32] << 16); } }
#pragma unroll
    for (int s = 0; s < 2; ++s) { f32x8v t;
#pragma unroll
        for (int jx = 0; jx < 8; ++jx) t[jx] = sc[8 * s + jx];
        const bf16x8s pf = __builtin_bit_cast(bf16x8s, __builtin_convertvector(t, bf16x8n));
        o0 = __builtin_amdgcn_mfma_f32_32x32x16_bf16(__builtin_bit_cast(bf16x8s, va[s]), pf, o0, 0, 0, 0);
        o1 = __builtin_amdgcn_mfma_f32_32x32x16_bf16(__builtin_bit_cast(bf16x8s, vb[s]), pf, o1, 0, 0, 0); }
}
__device__ __forceinline__ void attn_store_out(const f32x16& o0, const f32x16& o1, float inv, const bf16_t* __restrict__ gbase, int qt, bf16_t* __restrict__ yout, int b, int h, int hh) {
    uint2 gws[2][4];
#pragma unroll
    for (int dt = 0; dt < 2; ++dt)
#pragma unroll
        for (int g = 0; g < 4; ++g) gws[dt][g] = *(const uint2*)(gbase + qt * 64 + dt * 32 + 8 * g + 4 * hh);
#pragma unroll
    for (int dt = 0; dt < 2; ++dt)
#pragma unroll
        for (int g = 0; g < 4; ++g) { const int d0 = dt * 32 + 8 * g + 4 * hh;
            const uint2 gw = gws[dt][g];
            const float g0 = __uint_as_float(gw.x << 16), g1 = __uint_as_float(gw.x & 0xffff0000u), g2 = __uint_as_float(gw.y << 16), g3 = __uint_as_float(gw.y & 0xffff0000u);
            const float v0 = (dt ? o1[4 * g] : o0[4 * g]) * inv, v1 = (dt ? o1[4 * g + 1] : o0[4 * g + 1]) * inv, v2 = (dt ? o1[4 * g + 2] : o0[4 * g + 2]) * inv, v3 = (dt ? o1[4 * g + 3] : o0[4 * g + 3]) * inv;
            uint2 w; w.x = (unsigned)f2bf(v0 * silu(g0)) | ((unsigned)f2bf(v1 * silu(g1)) << 16); w.y = (unsigned)f2bf(v2 * silu(g2)) | ((unsigned)f2bf(v3 * silu(g3)) << 16);
            *(uint2*)(yout + (size_t)(b * SEQ + qt) * 1024 + h * 64 + d0) = w; }
}
template <class Pol, int MODE>
__device__ __forceinline__ void attn_wave_task(const bf16_t* __restrict__ proj, int b, int h, Pol pol, bf16_t* __restrict__ yout, int lane, float* __restrict__ X, LAS unsigned char* wl) {
    const int r = lane & 31, hh = lane >> 5, xaddr = (lane ^ 32) << 2;
    pol.init(r, hh);
    const int qt = pol.qtok(r);
    const bf16_t* qbase = proj + (size_t)(b * 16 + h) * (4096 * 64); const bf16_t* kbase = qbase + (size_t)T_TOK * 1024; const bf16_t* vbase = kbase + (size_t)T_TOK * 1024; const bf16_t* gbase = vbase + (size_t)T_TOK * 1024;
    bf16x8s qf[4];
#pragma unroll
    for (int s = 0; s < 4; ++s) qf[s] = *(const bf16x8s*)(qbase + qt * 64 + 16 * s + 8 * hh);
    f32x16 o0, o1;
    float m_run = -40.0f, l_run = 0.f;
    if (MODE == 2) { const float* xr = X + (size_t)pol.xrow(r) * 68;
#pragma unroll
        for (int g = 0; g < 4; ++g) { const float4 a0 = *(const float4*)(xr + 8 * g + 4 * hh), a1 = *(const float4*)(xr + 32 + 8 * g + 4 * hh);
            o0[4 * g] = a0.x; o0[4 * g + 1] = a0.y; o0[4 * g + 2] = a0.z; o0[4 * g + 3] = a0.w; o1[4 * g] = a1.x; o1[4 * g + 1] = a1.y; o1[4 * g + 2] = a1.z; o1[4 * g + 3] = a1.w; }
        m_run = xr[64]; l_run = hh == 0 ? xr[65] : 0.f;
    } else {
#pragma unroll
        for (int i = 0; i < 16; ++i) { o0[i] = 0.f; o1[i] = 0.f; } }
    constexpr int NB = Pol::NB;
    bf16x8s kf[4]; u32x4a vfA[4];
    attn_loadk<Pol>(kbase, pol, 0, r, hh, kf);
    attn_loadv<Pol>(vbase, pol, 0, r, hh, vfA);
#pragma unroll 1
    for (int fb = 0; fb < NB; ++fb)
        attn_compute<Pol>(kbase, pol, fb, fb + 1 < NB ? fb + 1 : NB - 1, (MODE != 2) && (fb == 0), r, hh, xaddr, qf, kf, vfA, vbase, wl, o0, o1, m_run, l_run);
    l_run += bperm_f(xaddr, l_run);
    if (MODE == 1) { float* xr = X + (size_t)pol.xrow(r) * 68;
#pragma unroll
        for (int g = 0; g < 4; ++g) { *(float4*)(xr + 8 * g + 4 * hh) = make_float4(o0[4 * g], o0[4 * g + 1], o0[4 * g + 2], o0[4 * g + 3]);
            *(float4*)(xr + 32 + 8 * g + 4 * hh) = make_float4(o1[4 * g], o1[4 * g + 1], o1[4 * g + 2], o1[4 * g + 3]); }
        if (hh == 0) { xr[64] = m_run; xr[65] = l_run; }
        return; }
    attn_store_out(o0, o1, 1.0f / l_run, gbase, qt, yout, b, h, hh);
}
#define SC2 (0.125f * 1.44269504088896341f)
#define CI32(i) (((i) & 3) + 8 * ((i) >> 2))
struct DilPolA { static constexpr int NB = 13; int t0, xq0; const LAS float* tbl16; const LAS float* tbl4;
    __device__ __forceinline__ void init(int, int) {}
    __device__ __forceinline__ int qtok(int n) const { return t0 + 16 * n; }
    __device__ __forceinline__ int xrow(int n) const { return xq0 + 16 * n; }
    __device__ __forceinline__ int stride(int fb) const { return fb < 5 ? 16 : 4; }
    __device__ __forceinline__ int kbof(int fb) const { return fb < 5 ? fb : fb - 5; }
    __device__ __forceinline__ int ktok(int fb, int ks) const { int t = t0 + stride(fb) * (-64 + 32 * kbof(fb) + ks); t = t < 0 ? 0 : (t > SEQ - 1 ? SEQ - 1 : t); return t; }
    __device__ __forceinline__ void scores(int fb, int n, int hh, f32x16& sc) const {
        const int st = stride(fb), kb = kbof(fb);
        const int brel = st * (-64 + 32 * kb + 4 * hh) - 16 * n, bidx = brel + 1536, tkb = t0 + st * (-64 + 32 * kb + 4 * hh);
        const int tlo = t0 + st * (-64 + 32 * kb); const bool edge = (tlo < 0) || (tlo + 31 * st > SEQ - 1);
        if (fb < 5) { const LAS float* tp = tbl16 + bidx + (bidx >> 4);
#pragma unroll
            for (int i = 0; i < 16; ++i) { float v = sc[i] * SC2 + tp[17 * CI32(i)]; if (edge) v = ((unsigned)(tkb + 16 * CI32(i)) < (unsigned)SEQ) ? v : -1e30f; sc[i] = v; }
        } else { const LAS float* tp = tbl4 + bidx + (bidx >> 4);
#pragma unroll
            for (int i = 0; i < 16; ++i) { float v = sc[i] * SC2 + tp[4 * CI32(i) + (CI32(i) >> 2)]; if (edge) v = ((unsigned)(tkb + 4 * CI32(i)) < (unsigned)SEQ) ? v : -1e30f; sc[i] = v; } }
        } };
struct DilPolB { static constexpr int NB = 5; int q0, xq0; const LAS float* tblB;
    __device__ __forceinline__ void init(int, int) {}
    __device__ __forceinline__ int qtok(int n) const { return q0 + n; }
    __device__ __forceinline__ int xrow(int n) const { return xq0 + n; }
    __device__ __forceinline__ int ktok(int fb, int ks) const { int t = q0 - 64 + 32 * fb + ks; t = t < 0 ? 0 : (t > SEQ - 1 ? SEQ - 1 : t); return t; }
    __device__ __forceinline__ void scores(int fb, int n, int hh, f32x16& sc) const {
        const int tlo = q0 - 64 + 32 * fb; const bool edge = (tlo < 0) || (tlo + 31 > SEQ - 1);
        const LAS float* tp = tblB + (-64 + 32 * fb + 4 * hh - n + 96); const int tkb = tlo + 4 * hh;
#pragma unroll
        for (int i = 0; i < 16; ++i) { float v = sc[i] * SC2 + tp[CI32(i)]; if (edge) v = ((unsigned)(tkb + CI32(i)) < (unsigned)SEQ) ? v : -1e30f; sc[i] = v; }
        } };
struct NatPol { static constexpr int NB = 9; int r0, c0, rs0, cw0; const LAS float* rpbh; int colmask, cbase, rq, rsq;
    __device__ __forceinline__ int xrow(int) const { return 0; }
    __device__ __forceinline__ void init(int n, int hh) { rq = r0 + (n >> 4); const int cq = c0 + (n & 15); rsq = rq - 4; rsq = rsq < 0 ? 0 : (rsq > 56 ? 56 : rsq); int csq = cq - 8; csq = csq < 0 ? 0 : (csq > 48 ? 48 : csq);
        cbase = cw0 + 4 * hh - cq + 15; int m = 0;
#pragma unroll
        for (int i = 0; i < 16; ++i) { const int ck = cw0 + 4 * hh + CI32(i); m |= (ck >= csq && ck < csq + 16) ? (1 << i) : 0; }
        colmask = m; }
    __device__ __forceinline__ int qtok(int n) const { return (r0 + (n >> 4)) * 64 + c0 + (n & 15); }
    __device__ __forceinline__ int ktok(int kb, int ks) const { int rk = rs0 + kb; rk = rk > 63 ? 63 : rk; return rk * 64 + cw0 + ks; }
    __device__ __forceinline__ void scores(int kb, int, int, f32x16& sc) const {
        const int rk = rs0 + kb; const bool rowok = rk >= rsq && rk < rsq + 8 && rk < 64; const int em = rowok ? colmask : 0;
        int ro = rk - rq + 7; ro = ro < 0 ? 0 : (ro > 14 ? 14 : ro); const LAS float* tp = rpbh + ro * 31 + cbase;
        float bv[16];
#pragma unroll
        for (int i = 0; i < 16; ++i) bv[i] = tp[CI32(i)];
#pragma unroll
        for (int i = 0; i < 16; ++i) { const float v = sc[i] * SC2 + bv[i]; sc[i] = (em & (1 << i)) ? v : -1e30f; }
        } };
__device__ __forceinline__ void natten_wave_task2(const bf16_t* __restrict__ proj, int b, int h, NatPol pA, NatPol pB, bf16_t* __restrict__ yout, int lane, LAS unsigned char* wl) {
    const int r = lane & 31, hh = lane >> 5, xaddr = (lane ^ 32) << 2;
    pA.init(r, hh); pB.init(r, hh);
    const int qtA = pA.qtok(r), qtB = pB.qtok(r);
    const bf16_t* qbase = proj + (size_t)(b * 16 + h) * (4096 * 64); const bf16_t* kbase = qbase + (size_t)T_TOK * 1024; const bf16_t* vbase = kbase + (size_t)T_TOK * 1024; const bf16_t* gbase = vbase + (size_t)T_TOK * 1024;
    bf16x8s qA[4], qB[4];
#pragma unroll
    for (int s = 0; s < 4; ++s) { qA[s] = *(const bf16x8s*)(qbase + qtA * 64 + 16 * s + 8 * hh); qB[s] = *(const bf16x8s*)(qbase + qtB * 64 + 16 * s + 8 * hh); }
    f32x16 oA0, oA1, oB0, oB1;
#pragma unroll
    for (int i = 0; i < 16; ++i) { oA0[i] = 0.f; oA1[i] = 0.f; oB0[i] = 0.f; oB1[i] = 0.f; }
    float mA = -40.0f, lA = 0.f, mB = -40.0f, lB = 0.f;
    constexpr int NB = 11;
    bf16x8s kf[4]; u32x4a vg[4];
    attn_loadk<NatPol>(kbase, pA, 0, r, hh, kf);
    attn_loadv<NatPol>(vbase, pA, 0, r, hh, vg);
#pragma unroll 1
    for (int fb = 0; fb < NB; ++fb) {
        const int fbn = fb + 1 < NB ? fb + 1 : NB - 1;
        f32x16 scA, scB;
#pragma unroll
        for (int i = 0; i < 16; ++i) { scA[i] = 0.f; scB[i] = 0.f; }
#pragma unroll
        for (int s = 0; s < 4; ++s) { scA = __builtin_amdgcn_mfma_f32_32x32x16_bf16(kf[s], qA[s], scA, 0, 0, 0); scB = __builtin_amdgcn_mfma_f32_32x32x16_bf16(kf[s], qB[s], scB, 0, 0, 0); }
        attn_loadk<NatPol>(kbase, pA, fbn, r, hh, kf);
        pA.scores(fb, r, hh, scA); pB.scores(fb, r, hh, scB);
        if (fb == 0) { float ba = scA[0], bb = scB[0];
#pragma unroll
            for (int i = 1; i < 16; ++i) { ba = fmaxf(ba, scA[i]); bb = fmaxf(bb, scB[i]); }
            ba = fmaxf(ba, bperm_f(xaddr, ba)); bb = fmaxf(bb, bperm_f(xaddr, bb)); mA = fmaxf(ba, -40.0f); mB = fmaxf(bb, -40.0f); }
        float psA = 0.f, psB = 0.f;
#pragma unroll
        for (int i = 0; i < 16; ++i) { const float pa = __builtin_amdgcn_exp2f(scA[i] - mA); scA[i] = pa; psA += pa; const float pb = __builtin_amdgcn_exp2f(scB[i] - mB); scB[i] = pb; psB += pb; }
        lA += psA; lB += psB;
        { asm volatile("" ::: "memory");
#pragma unroll
          for (int j = 0; j < 4; ++j) *(LAS u32x4a*)(wl + (8 * j + (lane >> 3)) * 144 + (lane & 7) * 16) = vg[j];
          asm volatile("" ::: "memory"); }
        attn_loadv<NatPol>(vbase, pA, fbn, r, hh, vg);
        u32x4a va[2], vb[2];
        { const LAS unsigned short* rp = (const LAS unsigned short*)(wl + (4 * hh) * 144 + r * 2);
#pragma unroll
          for (int s = 0; s < 2; ++s)
#pragma unroll
            for (int jx = 0; jx < 4; ++jx) { const int k0 = 16 * s + 8 * ((2 * jx) >> 2) + ((2 * jx) & 3), k1 = k0 + 1;
                va[s][jx] = (unsigned)rp[k0 * 72] | ((unsigned)rp[k1 * 72] << 16); vb[s][jx] = (unsigned)rp[k0 * 72 + 32] | ((unsigned)rp[k1 * 72 + 32] << 16); } }
#pragma unroll
        for (int s = 0; s < 2; ++s) { f32x8v ta, tb;
#pragma unroll
            for (int jx = 0; jx < 8; ++jx) { ta[jx] = scA[8 * s + jx]; tb[jx] = scB[8 * s + jx]; }
            const bf16x8s pfa = __builtin_bit_cast(bf16x8s, __builtin_convertvector(ta, bf16x8n)), pfb = __builtin_bit_cast(bf16x8s, __builtin_convertvector(tb, bf16x8n));
            oA0 = __builtin_amdgcn_mfma_f32_32x32x16_bf16(__builtin_bit_cast(bf16x8s, va[s]), pfa, oA0, 0, 0, 0);
            oA1 = __builtin_amdgcn_mfma_f32_32x32x16_bf16(__builtin_bit_cast(bf16x8s, vb[s]), pfa, oA1, 0, 0, 0);
            oB0 = __builtin_amdgcn_mfma_f32_32x32x16_bf16(__builtin_bit_cast(bf16x8s, va[s]), pfb, oB0, 0, 0, 0);
            oB1 = __builtin_amdgcn_mfma_f32_32x32x16_bf16(__builtin_bit_cast(bf16x8s, vb[s]), pfb, oB1, 0, 0, 0); }
    }
    lA += bperm_f(xaddr, lA); lB += bperm_f(xaddr, lB);
    attn_store_out(oA0, oA1, 1.0f / lA, gbase, qtA, yout, b, h, hh);
    attn_store_out(oB0, oB1, 1.0f / lB, gbase, qtB, yout, b, h, hh);
}
__device__ void ph_dilated_mfma(const Params& P, const bf16_t* __restrict__ proj, bf16_t* __restrict__ yout, unsigned char* lds_raw, float* __restrict__ Xall) {
    const int tid = otid(); const int lane = tid & 63, wid = tid >> 6;
    LAS float* tbl = (LAS float*)lds_raw; LAS unsigned char* wl = (LAS unsigned char*)lds_raw + 32768 + wid * 4608;
    const float* rel_bias = P.in[17];
    const int G = gridDim.x, bid = blockIdx.x, vb = (G % 8 == 0) ? (bid & 7) * (G >> 3) + (bid >> 3) : bid;
    float* X = Xall + (size_t)bid * 512 * 68;
#pragma unroll 1
    for (int bt = vb; bt < 1024; bt += G) {
        const int p = bt >> 3, chunk = bt & 7, b = p >> 4, h = p & 15;
        __syncthreads();
        LAS float* tbl16 = tbl; LAS float* tbl4 = tbl + 3328; LAS float* tblB = tbl + 6656;
        for (int x = tid; x < 3073; x += NT) { const int rel = x - 1536, ar = rel < 0 ? -rel : rel; const float bv = rel_bias[t5_bucket(rel) * 16 + h] * 1.44269504088896341f;
            tbl16[x + (x >> 4)] = ((rel & 15) == 0 && ar <= 1024) ? bv : -1e30f; tbl4[x + (x >> 4)] = ((rel & 3) == 0 && ar <= 256) ? bv : -1e30f; }
        for (int x = tid; x < 256; x += NT) { const int rel = x - 96, ar = rel < 0 ? -rel : rel; tblB[x] = (ar <= 64) ? rel_bias[t5_bucket(rel) * 16 + h] * 1.44269504088896341f : -1e30f; }
        __syncthreads();
#pragma unroll 1
        for (int rr = 0; rr < 2; ++rr) { const int res = wid * 2 + rr; DilPolA pol{chunk * 512 + res, res, tbl16, tbl4}; attn_wave_task<DilPolA, 1>(proj, b, h, pol, yout, lane, X, wl); }
        __syncthreads();
#pragma unroll 1
        for (int rr = 0; rr < 2; ++rr) { const int qs = (wid * 2 + rr) * 32; DilPolB pol{chunk * 512 + qs, qs, tblB}; attn_wave_task<DilPolB, 2>(proj, b, h, pol, yout, lane, X, wl); }
    }
}
__device__ void ph_natten_mfma(const Params& P, int j, int half, const bf16_t* __restrict__ proj, bf16_t* __restrict__ yout, unsigned char* lds_raw) {
    const int tid = otid(); const int lane = tid & 63, wid = tid >> 6;
    LAS float* tbl = (LAS float*)lds_raw; LAS unsigned char* wl = (LAS unsigned char*)lds_raw + 32768 + wid * 4608;
    const float* rpb = P.in[18] + (size_t)j * 32 * 15 * 31;
    const int G = gridDim.x, bid = blockIdx.x, vb = (G % 8 == 0) ? (bid & 7) * (G >> 3) + (bid >> 3) : bid;
#pragma unroll 1
    for (int id0 = vb * 8; id0 < 8192; id0 += G * 8) {
        const int p = id0 >> 6, b = p >> 4, h = p & 15, wt = (id0 & 63) + wid;
        __syncthreads();
        for (int x = tid; x < 465; x += NT) tbl[64 + x] = rpb[(size_t)(half * 16 + h) * 465 + x] * 1.44269504088896341f;
        __syncthreads();
        const int r0 = (wt >> 2) * 4, c0 = (wt & 3) * 16;
        int rs0 = r0 - 4; rs0 = rs0 < 0 ? 0 : (rs0 > 56 ? 56 : rs0); int cw0 = c0 - 8; cw0 = cw0 < 0 ? 0 : (cw0 > 32 ? 32 : cw0);
        NatPol polA{r0, c0, rs0, cw0, tbl + 64, 0, 0, 0, 0}, polB{r0 + 2, c0, rs0, cw0, tbl + 64, 0, 0, 0, 0};
        natten_wave_task2(proj, b, h, polA, polB, yout, lane, wl);
    }
}

__device__ __forceinline__ void unpack8(const uint4& w, float (&f)[8]) {
    f[0] = __uint_as_float(w.x << 16); f[1] = __uint_as_float(w.x & 0xffff0000u); f[2] = __uint_as_float(w.y << 16); f[3] = __uint_as_float(w.y & 0xffff0000u);
    f[4] = __uint_as_float(w.z << 16); f[5] = __uint_as_float(w.z & 0xffff0000u); f[6] = __uint_as_float(w.w << 16); f[7] = __uint_as_float(w.w & 0xffff0000u); }
__device__ void ph_post(const float* hin_f, const bf16_t* hin_b, const bf16_t* t1, const float* gpost, bf16_t* E, const float* gple, bf16_t* h1b) {
    const int tid = otid(); const int lane = tid & 63, wid = tid >> 6;
    const bool xaff = (gridDim.x == 256);
    const int row_first = xaff ? (((int)blockIdx.x & 7) << 12) + (((int)blockIdx.x >> 3) << 3) + wid : (int)blockIdx.x * 8 + wid;
    const int row_step = xaff ? 256 : (int)gridDim.x * 8, row_end = xaff ? ((((int)blockIdx.x & 7) + 1) << 12) : T_TOK;
    for (int row = row_first; row < row_end; row += row_step) {
        const size_t ro = (size_t)row * DM;
        uint4 tw[2], ew[2]; float hv[2][8];
#pragma unroll
        for (int i = 0; i < 2; ++i) { const int e0 = (lane + 64 * i) * 8; tw[i] = ntld_u4(t1 + ro + e0); ew[i] = ntld_u4(E + ro + e0); }
        if (hin_b) {
#pragma unroll
            for (int i = 0; i < 2; ++i) { const uint4 hw = ntld_u4(hin_b + ro + (lane + 64 * i) * 8); unpack8(hw, hv[i]); }
        } else {
#pragma unroll
            for (int i = 0; i < 2; ++i) { const int e0 = (lane + 64 * i) * 8; const float4 a = *(const float4*)(hin_f + ro + e0), b = *(const float4*)(hin_f + ro + e0 + 4);
                hv[i][0] = a.x; hv[i][1] = a.y; hv[i][2] = a.z; hv[i][3] = a.w; hv[i][4] = b.x; hv[i][5] = b.y; hv[i][6] = b.z; hv[i][7] = b.w; } }
        float tv[2][8], ev[2][8]; float ss = 0.f, se = 0.f;
#pragma unroll
        for (int i = 0; i < 2; ++i) { unpack8(tw[i], tv[i]); unpack8(ew[i], ev[i]);
#pragma unroll
            for (int k = 0; k < 8; ++k) { ss += tv[i][k] * tv[i][k]; se += ev[i][k] * ev[i][k]; } }
        ss = wave_sum(ss); se = wave_sum(se);
        const float r = rsqrtf(ss * (1.0f / DM) + RMS_EPS), re = rsqrtf(se * (1.0f / DM) + RMS_EPS);
        float4 gaa[2], gbb[2], paa[2], pbb[2];
#pragma unroll
        for (int i = 0; i < 2; ++i) { const int e0 = (lane + 64 * i) * 8; gaa[i] = *(const float4*)(gpost + e0); gbb[i] = *(const float4*)(gpost + e0 + 4); paa[i] = *(const float4*)(gple + e0); pbb[i] = *(const float4*)(gple + e0 + 4); }
#pragma unroll
        for (int i = 0; i < 2; ++i) { const int e0 = (lane + 64 * i) * 8;
            const float4 ga = gaa[i], gb = gbb[i], pa = paa[i], pb = pbb[i];
            const float gg[8] = {ga.x, ga.y, ga.z, ga.w, gb.x, gb.y, gb.z, gb.w}, pp[8] = {pa.x, pa.y, pa.z, pa.w, pb.x, pb.y, pb.z, pb.w};
            float o[8], x[8];
#pragma unroll
            for (int k = 0; k < 8; ++k) { o[k] = hv[i][k] + tv[i][k] * r * gg[k]; x[k] = ev[i][k] * re * pp[k]; }
            uint4 w; w.x = pg8::cvt_pk_bf16(o[0], o[1]); w.y = pg8::cvt_pk_bf16(o[2], o[3]); w.z = pg8::cvt_pk_bf16(o[4], o[5]); w.w = pg8::cvt_pk_bf16(o[6], o[7]);
            *(uint4*)(h1b + ro + e0) = w;
            uint4 xx; xx.x = pg8::cvt_pk_bf16(x[0], x[1]); xx.y = pg8::cvt_pk_bf16(x[2], x[3]); xx.z = pg8::cvt_pk_bf16(x[4], x[5]); xx.w = pg8::cvt_pk_bf16(x[6], x[7]);
            *(uint4*)(E + ro + e0) = xx; }
    }
}

#define XB_TMO      128
#define XB_XCNT(j)  (256  + 64 * (j))
#define XB_XSUB(j)  (1280 + 64 * (j))
#define XB_XGEN(j)  (2304 + 64 * (j))
#define XB_TOP      3328
#define XB_TOPGEN   3392
#define XCD_BAR_WORDS 3456
#define XB_SPIN_CAP (1u << 18)
__device__ __forceinline__ unsigned xb_ld(unsigned* p)              { return __hip_atomic_load(p, __ATOMIC_RELAXED, __HIP_MEMORY_SCOPE_AGENT); }
__device__ __forceinline__ unsigned xb_add(unsigned* p, unsigned v) { return __hip_atomic_fetch_add(p, v, __ATOMIC_RELAXED, __HIP_MEMORY_SCOPE_AGENT); }
__device__ __forceinline__ unsigned xb_xcc_id() { return (unsigned)__builtin_amdgcn_s_getreg((3 << 11) | 20) & 0xFu; }
#define XB_SPIN(cond, bar) do { unsigned _sp = 0; while (cond) { __builtin_amdgcn_s_sleep(1); \
    if ((++_sp & 255u) == 0u) { if (xb_ld(&(bar)[XB_TMO])) break; if (_sp > XB_SPIN_CAP) { atomicAdd(&(bar)[XB_TMO], 1u); break; } } } } while (0)
struct XcdBarrier { unsigned* bar; unsigned x; volatile LAS unsigned* st; };
__device__ __forceinline__ XcdBarrier xcd_barrier_post(unsigned* bar, volatile LAS unsigned* st) {
    XcdBarrier b; b.bar = bar; b.x = xb_xcc_id(); b.st = st;
    if (threadIdx.x == 0) (void)xb_add(&bar[XB_XCNT(b.x)], 1u);
    return b;
}
__device__ __forceinline__ void xcd_barrier_complete(unsigned* bar, unsigned x, unsigned& nloc, unsigned& nx) {
    const unsigned G = gridDim.x * gridDim.y * gridDim.z;
    unsigned sum, cnt, mine, sp = 0u;
    for (;;) {
        sum = 0u; cnt = 0u; mine = 0u;
#pragma unroll
        for (unsigned j = 0; j < 16; ++j) { const unsigned c = xb_ld(&bar[XB_XCNT(j)]); sum += c; cnt += (c > 0u) ? 1u : 0u; mine = (j == x) ? c : mine; }
        if (sum == G) break;
        __builtin_amdgcn_s_sleep(1);
        if ((++sp & 255u) == 0u) { if (xb_ld(&bar[XB_TMO])) break; if (sp > XB_SPIN_CAP) { atomicAdd(&bar[XB_TMO], 1u); break; } }
    }
    nloc = mine > 0u ? mine : 1u; nx = cnt > 0u ? cnt : 1u;
}
__device__ __forceinline__ void xcd_barrier(const XcdBarrier& b) {
    asm volatile("s_waitcnt vmcnt(0)" ::: "memory");
    __syncthreads();
    if (threadIdx.x == 0) {
        unsigned* bar = b.bar;
        __builtin_amdgcn_s_waitcnt(0);
        unsigned nloc = b.st[0], nx = b.st[1];
        if (nloc == 0u) { xcd_barrier_complete(bar, b.x, nloc, nx); b.st[0] = nloc; b.st[1] = nx; }
        const unsigned old = xb_add(&bar[XB_XSUB(b.x)], 1u);
        const unsigned gen = old / nloc;
        if (old + 1u == (gen + 1u) * nloc) {
            __builtin_amdgcn_fence(__ATOMIC_RELEASE, "agent");
            asm volatile("s_waitcnt vmcnt(0)" ::: "memory");
            const unsigned og = xb_add(&bar[XB_TOP], 1u);
            const unsigned tg = og / nx;
            if (og + 1u == (tg + 1u) * nx) xb_add(&bar[XB_TOPGEN], 1u);
            else XB_SPIN(xb_ld(&bar[XB_TOPGEN]) == tg, bar);
            __builtin_amdgcn_fence(__ATOMIC_ACQUIRE, "agent");
            xb_add(&bar[XB_XGEN(b.x)], 1u);
            asm volatile("s_waitcnt vmcnt(0)" ::: "memory");
        } else {
            XB_SPIN(xb_ld(&bar[XB_XGEN(b.x)]) == gen, bar);
            __builtin_amdgcn_fence(__ATOMIC_ACQUIRE, "agent");
            asm volatile("s_waitcnt vmcnt(0)" ::: "memory");
        }
    }
    __syncthreads();
}
__device__ __forceinline__ void grid_bar(unsigned* ctr, unsigned& epoch, unsigned G) {
    __syncthreads();
    if (threadIdx.x == 0) {
        epoch += 1u;
        __threadfence();
        __hip_atomic_fetch_add(ctr, 1u, __ATOMIC_RELAXED, __HIP_MEMORY_SCOPE_AGENT);
        const unsigned target = epoch * G;
        while (__hip_atomic_load(ctr, __ATOMIC_RELAXED, __HIP_MEMORY_SCOPE_AGENT) < target) __builtin_amdgcn_s_sleep(1);
        __threadfence();
    }
    __syncthreads();
}
__global__ void __launch_bounds__(NT) fwd_megakernel(Params P) {
    extern __shared__ __attribute__((aligned(16))) unsigned char lds_raw[];
    cg::grid_group grid = cg::this_grid();
    PG8_LAS unsigned char* lds = (PG8_LAS unsigned char*)lds_raw;
    float* sl = (float*)lds_raw;
    unsigned char* ws = P.ws;
    const int G = gridDim.x, bid = blockIdx.x;
    bf16_t* U = (bf16_t*)(ws + WS_U); bf16_t* PROJ = (bf16_t*)(ws + WS_PROJ); bf16_t* T1 = (bf16_t*)(ws + WS_T1); bf16_t* E = (bf16_t*)(ws + WS_E);
    bf16_t* YA = (bf16_t*)(ws + WS_YA); bf16_t* YB = (bf16_t*)(ws + WS_YB); float* KF = (float*)(ws + WS_YA);
    bf16_t* WIN = (bf16_t*)(ws + WS_WIN); bf16_t* WOUT = (bf16_t*)(ws + WS_WOUT); bf16_t* PPROJ = (bf16_t*)(ws + WS_PPROJ); bf16_t* PGATE = (bf16_t*)(ws + WS_PGATE);
    bf16_t* PB = (bf16_t*)(ws + WS_PB); float* A3 = (float*)(ws + WS_A3);
    int ph = 0;
    volatile LAS unsigned* xst = (volatile LAS unsigned*)((LAS unsigned char*)lds_raw + 144 * 1024);
    if (threadIdx.x < 4) xst[threadIdx.x] = 0u;
    __syncthreads();
    const XcdBarrier xbar = xcd_barrier_post((unsigned*)(ws + WS_CTL), xst);
#define PHASE_BEGIN if (ph >= P.ph_lo && ph < P.ph_hi) {
#define PHASE_END   if (ph + 1 < P.ph_hi) { if (P.ph_hi < 0) grid.sync(); else xcd_barrier(xbar); } } ++ph;
#pragma unroll 1
    for (int layer = 0; layer < 4; ++layer) {
        const bool even = !(layer & 1); const int j = layer >> 1;
        bf16_t* HBUF = (bf16_t*)P.out;
        PHASE_BEGIN
#pragma unroll 1
            for (int rep = 0; rep < ((REP_MASK & 8) ? 2 : 1); ++rep) {
            if (layer == 0) ph_rmsnorm_rows(P.in[0], P.in[4] + layer * DM, U); else ph_rmsnorm_rows_b16(HBUF, P.in[4] + layer * DM, U);
            ph_prep_weights(P, layer, sl);
            ph_convert_p(P.in[1] + (size_t)layer * T_TOK * PLE, PB);
            if (even) ph_filter_mlp(P, j, A3);
            }
            if (REP_MASK & 16) { for (int rep = 0; rep < 8; ++rep) grid.sync(); }
        PHASE_END
        PHASE_BEGIN
            pg8::StaticOrder S; pg8::Gemm g; pg8::EpiBf16 Ep;
            if (even) { g = pg8::Gemm{WIN, U, 4096, T_TOK, 1024, 1024, 1 << 20, 0ll}; Ep = pg8::EpiBf16{PROJ, (size_t)T_TOK, 0}; S.init(4096, T_TOK, G, bid); }
            else      { g = pg8::Gemm{U, WIN, T_TOK, 4096, 1024, 1024, 1 << 20, 0ll}; Ep = pg8::EpiBf16{PROJ, (size_t)4096, 1}; S.init(T_TOK, 4096, G, bid); }
#pragma unroll 1
            for (int rep = 0; rep < ((REP_MASK & 1) ? 2 : 1); ++rep)
            pg8::gemm_phase<pg8::EpiBf16, pg8::StaticOrder>(lds, g, S, Ep);
#pragma unroll 1
            for (int rep = 0; rep < ((REP_MASK & 32) ? 2 : 1); ++rep)
            if (even) { __syncthreads(); ph_filter_gen(P, j, A3, KF, sl); }
        PHASE_END
        PHASE_BEGIN
            #if HY_FFT
#pragma unroll 1
            for (int rep = 0; rep < ((REP_MASK & 2) ? 2 : 1); ++rep)
            if (even) ph_hyena_fft(P, j, PROJ, KF, YB, lds_raw);
#else
            if (even) ph_hyena_naive(P, j, PROJ, KF, YB, sl);
#endif
#if ATT_MFMA
#pragma unroll 1
            for (int rep = 0; rep < (((REP_MASK & 4) || ((REP_MASK & 64) && !even)) ? 2 : 1); ++rep)
            if (!even) ph_natten_mfma(P, j, 0, PROJ, YA, lds_raw);
#else
            else ph_natten_naive(P, j, 0, PROJ, YA);
#endif
        PHASE_END
        PHASE_BEGIN
            pg8::StaticOrder S; S.init(T_TOK, 4096, G, bid);
            pg8::Gemm g{U, WIN + (size_t)4096 * 1024, T_TOK, 4096, 1024, 1024, 1 << 20, 0ll}; pg8::EpiBf16 Ep{PROJ, (size_t)4096, 1};
#pragma unroll 1
            for (int rep = 0; rep < ((REP_MASK & 1) ? 2 : 1); ++rep)
            pg8::gemm_phase<pg8::EpiBf16, pg8::StaticOrder>(lds, g, S, Ep);
#pragma unroll 1
            for (int rep = 0; rep < ((REP_MASK & 32) ? 2 : 1); ++rep)
            if (even) { __syncthreads(); ph_transpose_ya(YB, YA, (bf16_t*)lds_raw); }
        PHASE_END
        PHASE_BEGIN
#if ATT_MFMA
#pragma unroll 1
            for (int rep = 0; rep < (((REP_MASK & 4) || ((REP_MASK & 64) && !even) || ((REP_MASK & 128) && even)) ? 2 : 1); ++rep) {
            if (even) ph_dilated_mfma(P, PROJ, YB, lds_raw, (float*)(ws + WS_U));
            else ph_natten_mfma(P, j, 1, PROJ, YB, lds_raw);
            }
#else
            if (even) ph_dilated_naive(P, PROJ, YB);
            else ph_natten_naive(P, j, 1, PROJ, YB);
#endif
        PHASE_END
        PHASE_BEGIN
#pragma unroll 1
            for (int qq = 0; qq < ((REP_MASK & 1) ? 4 : 2); ++qq) { const int q = qq & 1;
                pg8::StaticOrder S; S.init(T_TOK, 1024, G, bid);
                pg8::Gemm g = q == 0 ? pg8::Gemm{YA, WOUT, T_TOK, 1024, 2048, 1024, 16, (long long)(WS_YB - WS_YA) - 16ll * 128}
                                     : pg8::Gemm{PB, PPROJ, T_TOK, 1024, 256, 256, 1 << 20, 0ll};
                pg8::EpiBf16 Ep{q == 0 ? T1 : E, (size_t)1024, 0};
                pg8::gemm_phase<pg8::EpiBf16, pg8::StaticOrder>(lds, g, S, Ep);
            }
        PHASE_END
        PHASE_BEGIN
            ph_post(P.in[0], layer == 0 ? (const bf16_t*)nullptr : (const bf16_t*)HBUF, T1, P.in[5] + layer * DM, E, P.in[20] + layer * DM, U);
        PHASE_END
        PHASE_BEGIN
            pg8::StaticOrder S; S.init(T_TOK, 1024, G, bid);
            pg8::Gemm g{U, PGATE, T_TOK, 1024, 1024, 1024, 1 << 20, 0ll}; pg8::EpiGate Ep{U, E, HBUF, layer == 3 ? P.out : (float*)nullptr, 1024};
            pg8::gemm_phase<pg8::EpiGate, pg8::StaticOrder>(lds, g, S, Ep);
        PHASE_END
    }
}

extern "C" void kernel_launch(void* const* d_in, const int* in_sizes, int n_in, void* d_out, int out_size, void* d_ws, size_t ws_size, hipStream_t stream) {
    static int grid_blocks = 0;
    if (grid_blocks == 0) {
        if (n_in != 22 || ws_size < WS_END) { fprintf(stderr, "kernel_launch: unexpected n_in %d / ws_size %zu\n", n_in, ws_size); grid_blocks = -1; return; }
        int dev = 0, cus = 0, per_cu = 0;
        hipGetDevice(&dev); hipDeviceGetAttribute(&cus, hipDeviceAttributeMultiprocessorCount, dev);
        if (hipFuncSetAttribute((const void*)fwd_megakernel, hipFuncAttributeMaxDynamicSharedMemorySize, LDS_BYTES) != hipSuccess) { fprintf(stderr, "hipFuncSetAttribute failed\n"); grid_blocks = -1; return; }
        if (hipOccupancyMaxActiveBlocksPerMultiprocessor(&per_cu, (const void*)fwd_megakernel, NT, LDS_BYTES) != hipSuccess || per_cu < 1) { fprintf(stderr, "occupancy query: %d\n", per_cu); per_cu = 1; }
        (void)hipGetLastError();
        grid_blocks = cus;
    }
    if (grid_blocks < 0) return;
    if (hipMemsetAsync((char*)d_ws + WS_CTL, 0, XCD_BAR_WORDS * 4, stream) != hipSuccess) { fprintf(stderr, "memset failed\n"); return; }
    Params p{};
    for (int i = 0; i < 22; ++i) p.in[i] = (const float*)d_in[i];
    p.out = (float*)d_out; p.ws = (unsigned char*)d_ws; p.ph_lo = 0; p.ph_hi = 32;
    void* args[] = {&p};
    hipError_t e = hipLaunchCooperativeKernel((const void*)fwd_megakernel, dim3(grid_blocks), dim3(NT), args, LDS_BYTES, stream);
    if (e != hipSuccess) fprintf(stderr, "cooperative launch failed: %s (grid %d)\n", hipGetErrorString(e), grid_blocks);
}
```

```cpp
#include <hip/hip_runtime.h>
#include <hip/hip_cooperative_groups.h>
#include <cstdio>
#include <cstdint>
namespace cg = cooperative_groups;

#ifndef REP_MASK
#define REP_MASK 0
#endif
#ifndef HY_FFT
#define HY_FFT 1
#endif
#ifndef ATT_MFMA
#define ATT_MFMA 1
#endif

namespace pg8 {
#define PG8_LAS __attribute__((address_space(3)))
typedef unsigned short bf16_t;
typedef short bf16x8 __attribute__((ext_vector_type(8)));
typedef float f32x4 __attribute__((ext_vector_type(4)));
typedef unsigned u32x4 __attribute__((ext_vector_type(4)));
constexpr int BM = 256, BK = 64, HALF = 128, HTB = HALF * BK * 2, STAGE_BYTES = 8 * HTB, NXCD = 8, WGM = 8;

__host__ __device__ __forceinline__ int lds_byte(int r, int c) { const int st = (r >> 4) * 2 + (c >> 5), rr = r & 15, cc = c & 31, ob = rr * 64 + cc * 2; return st * 1024 + (ob ^ (((ob >> 9) & 1) << 5)); }
__host__ __device__ __forceinline__ void stage_rc(int b, int& R, int& C) { const int st = b / 1024, sb = b % 1024, swz = sb ^ (((sb >> 9) & 1) << 5); R = (st >> 1) * 16 + swz / 64; C = (st & 1) * 32 + (swz % 64) / 2; }
__host__ __device__ __forceinline__ int perm32(int rho) { const int n = rho >> 4, i = rho & 15; return 8 * (i >> 2) + 4 * n + (i & 3); }

struct Unit { int pm, pn; };
struct Gemm { const bf16_t* A; const bf16_t* Bt; int M, N, K, lda, ksplit; long long adj; };

struct StaticOrder {
    int nM, nN, nwg, G, c;
    __host__ __device__ void init(int M, int N, int G_, int c_) { nM = M / BM; nN = N / BM; nwg = nM * nN; G = G_; c = c_; }
    __host__ __device__ bool next(int i, Unit& u) const {
        const long L = (long)i * G + c; if (L >= nwg) return false;
        int wgid = (int)L; { const int q = nwg / NXCD, r = nwg % NXCD, xcd = wgid % NXCD, off = wgid / NXCD; wgid = (xcd < r ? xcd * (q + 1) : r * (q + 1) + (xcd - r) * q) + off; }
        const int nig = WGM * nN, gid = wgid / nig, fm = gid * WGM, gsz = (nM - fm) < WGM ? (nM - fm) : WGM;
        u.pm = fm + ((wgid % nig) % gsz); u.pn = (wgid % nig) / gsz; return true;
    }
};

__device__ __forceinline__ unsigned cvt_pk_bf16(float lo, float hi) { unsigned r; asm volatile("v_cvt_pk_bf16_f32 %0, %1, %2" : "=v"(r) : "v"(lo), "v"(hi)); return r; }

struct EpiF32 {
    static constexpr bool PERM = false;
    float* C; int ldc;
    __device__ __forceinline__ void operator()(const f32x4 (&acc)[2][2][4][2], const Unit& u, int wr, int wc, int fr, int fq) const {
        const int row0 = u.pm * BM + wr * 64 + fr, col0 = u.pn * BM + wc * 32 + 4 * fq;
#pragma unroll
        for (int ai = 0; ai < 2; ++ai)
#pragma unroll
            for (int m = 0; m < 4; ++m) { float* rowp = C + (size_t)(row0 + ai * HALF + m * 16) * ldc + col0;
#pragma unroll
                for (int bj = 0; bj < 2; ++bj)
#pragma unroll
                    for (int n = 0; n < 2; ++n) *(f32x4*)(rowp + bj * HALF + n * 16) = acc[ai][bj][m][n]; }
    }
};
struct EpiBf16 {
    static constexpr bool PERM = true;
    bf16_t* O; size_t ldc; int mode;
    __device__ __forceinline__ size_t rowterm(int row) const { return mode ? ((size_t)(row >> 12) * (16 * 4096 * 64) + (size_t)(row & 4095) * 64) : (size_t)row * ldc; }
    __device__ __forceinline__ size_t colterm(int col) const { return mode ? ((size_t)(col >> 10) * ((size_t)32768 * 1024) + (size_t)((col >> 6) & 15) * (4096 * 64) + (col & 63)) : (size_t)col; }
    __device__ __forceinline__ void operator()(const f32x4 (&acc)[2][2][4][2], const Unit& u, int wr, int wc, int fr, int fq) const {
        const int row0 = u.pm * BM + wr * 64 + fr; const int col0 = u.pn * BM + wc * 32 + 8 * fq;
        const size_t ct0 = colterm(col0), ct1 = colterm(col0 + HALF);
#pragma unroll
        for (int ai = 0; ai < 2; ++ai)
#pragma unroll
            for (int m = 0; m < 4; ++m) { bf16_t* rowp = O + rowterm(row0 + ai * HALF + m * 16);
#pragma unroll
                for (int bj = 0; bj < 2; ++bj) { const f32x4 v0 = acc[ai][bj][m][0], v1 = acc[ai][bj][m][1];
                    u32x4 w; w.x = cvt_pk_bf16(v0[0], v0[1]); w.y = cvt_pk_bf16(v0[2], v0[3]); w.z = cvt_pk_bf16(v1[0], v1[1]); w.w = cvt_pk_bf16(v1[2], v1[3]);
                    *(u32x4*)(rowp + (bj ? ct1 : ct0)) = w; } }
    }
};
struct EpiGate {
    static constexpr bool PERM = true;
    const bf16_t* H1; const bf16_t* E; bf16_t* HB; float* HF; int ldc;
    __device__ __forceinline__ void operator()(const f32x4 (&acc)[2][2][4][2], const Unit& u, int wr, int wc, int fr, int fq) const {
        const int row0 = u.pm * BM + wr * 64 + fr, col0 = u.pn * BM + wc * 32 + 8 * fq;
#pragma unroll
        for (int ai = 0; ai < 2; ++ai) {
            u32x4 hws[4][2], ews[4][2];
#pragma unroll
            for (int m = 0; m < 4; ++m)
#pragma unroll
                for (int bj = 0; bj < 2; ++bj) { const size_t o = (size_t)(row0 + ai * HALF + m * 16) * ldc + col0 + bj * HALF; hws[m][bj] = *(const u32x4*)(H1 + o); ews[m][bj] = *(const u32x4*)(E + o); }
#pragma unroll
            for (int m = 0; m < 4; ++m) { const size_t off = (size_t)(row0 + ai * HALF + m * 16) * ldc + col0;
#pragma unroll
                for (int bj = 0; bj < 2; ++bj) { const size_t o = off + bj * HALF; const u32x4 hw = hws[m][bj]; const u32x4 ew = ews[m][bj];
                    float r[8];
#pragma unroll
                    for (int q = 0; q < 4; ++q) { const float h0 = __uint_as_float(hw[q] << 16), h1 = __uint_as_float(hw[q] & 0xffff0000u), e0 = __uint_as_float(ew[q] << 16), e1 = __uint_as_float(ew[q] & 0xffff0000u);
                        const float g0 = acc[ai][bj][m][q >> 1][(q & 1) * 2], g1 = acc[ai][bj][m][q >> 1][(q & 1) * 2 + 1];
                        r[2 * q] = h0 + e0 * __builtin_amdgcn_rcpf(1.0f + __expf(-g0)); r[2 * q + 1] = h1 + e1 * __builtin_amdgcn_rcpf(1.0f + __expf(-g1)); }
                    if (HF) { *(f32x4*)(HF + o) = (f32x4){r[0], r[1], r[2], r[3]}; *(f32x4*)(HF + o + 4) = (f32x4){r[4], r[5], r[6], r[7]}; }
                    else { u32x4 w; w.x = cvt_pk_bf16(r[0], r[1]); w.y = cvt_pk_bf16(r[2], r[3]); w.z = cvt_pk_bf16(r[4], r[5]); w.w = cvt_pk_bf16(r[6], r[7]); *(u32x4*)(HB + o) = w; } } } }
    }
};

template <class Epi, class Sched, bool ALIGN_EPI = true, bool SP2 = true>
__device__ __forceinline__ void gemm_phase(PG8_LAS unsigned char* lds, const Gemm g, const Sched& S, const Epi& E) {
    int tid_ = threadIdx.x; asm volatile("" : "+v"(tid_));
    const int tid = tid_, wid = __builtin_amdgcn_readfirstlane(tid >> 6), lane = tid & 63, wr = wid >> 2, wc = wid & 3, fr = lane & 15, fq = lane >> 4;
    const int K = g.K, nt = K / BK, lda = g.lda, ksplit = g.ksplit; const long long adj = g.adj;
    unsigned voffA[2], voffB[2];
#pragma unroll
    for (int i = 0; i < 2; ++i) { int R, C; stage_rc(tid * 16 + i * 8192, R, C); const int Rb = Epi::PERM ? ((R & ~31) + perm32(R & 31)) : R;
        voffA[i] = (unsigned)(R * lda + C) * 2u; voffB[i] = (unsigned)(Rb * K + C) * 2u; }
    const size_t kstep = (size_t)(BK * 2);
    const size_t hstepA = (size_t)HALF * lda * 2, hstepB = (size_t)HALF * K * 2;
    const size_t tstepA = 2 * hstepA, tstepB = 2 * hstepB;
    const unsigned ldsw = (unsigned)wid * 1024u;
    const int aoff = lds_byte(wr * 64 + fr, fq * 8), boff = lds_byte(wc * 32 + fr, fq * 8);
#define PG8_SA(b, h) (((b) * 2 + (h)) * HTB)
#define PG8_SB(b, h) ((4 + (b) * 2 + (h)) * HTB)
#define PG8_STAGE(bufoff, gbase, voff) do { _Pragma("unroll") for (int _i = 0; _i < 2; ++_i) \
        __builtin_amdgcn_global_load_lds((const unsigned*)((const char*)(gbase) + (voff)[_i]), (PG8_LAS unsigned*)(lds + (bufoff) + ldsw + _i * 8192), 16, 0, 0); } while (0)
#define PG8_LDA(dst, b, h) do { _Pragma("unroll") for (int m = 0; m < 4; ++m) _Pragma("unroll") for (int k = 0; k < 2; ++k) dst[m][k] = *(const PG8_LAS bf16x8*)(lds + PG8_SA(b, h) + aoff + m * 2048 + k * 1024); } while (0)
#define PG8_LDB(dst, b, h) do { _Pragma("unroll") for (int n = 0; n < 2; ++n) _Pragma("unroll") for (int k = 0; k < 2; ++k) dst[n][k] = *(const PG8_LAS bf16x8*)(lds + PG8_SB(b, h) + boff + n * 2048 + k * 1024); } while (0)
#define PG8_MMA(ai, bj, At, Bt) do { __builtin_amdgcn_s_setprio(1); _Pragma("unroll") for (int m = 0; m < 4; ++m) _Pragma("unroll") for (int n = 0; n < 2; ++n) _Pragma("unroll") for (int k = 0; k < 2; ++k) \
        acc[ai][bj][m][n] = __builtin_amdgcn_mfma_f32_16x16x32_bf16(Bt[n][k], At[m][k], acc[ai][bj][m][n], 0, 0, 0); __builtin_amdgcn_s_setprio(0); } while (0)
#define PG8_WAIT_V(n) asm volatile("s_waitcnt vmcnt(" #n ")" ::: "memory")
#define PG8_WAIT_L(n) asm volatile("s_waitcnt lgkmcnt(" #n ")" ::: "memory")
#define PG8_BAR __builtin_amdgcn_s_barrier()
#define PG8_SCHED __builtin_amdgcn_sched_barrier(0)
#define PG8_ATILE(base, tt) ((base) + (size_t)(tt) * kstep + (((tt) >= ksplit) ? adj : 0ll))
    Unit cur, nxt; int ui = 0;
    if (!S.next(0, cur)) return;
    f32x4 acc[2][2][4][2];
#pragma unroll
    for (int a = 0; a < 2; ++a)
#pragma unroll
        for (int b = 0; b < 2; ++b)
#pragma unroll
            for (int m = 0; m < 4; ++m)
#pragma unroll
                for (int n = 0; n < 2; ++n) acc[a][b][m][n] = (f32x4){0.f, 0.f, 0.f, 0.f};
    bf16x8 At[4][2], B0[2][2], B1[2][2];
    const char* cA = (const char*)g.A + (size_t)cur.pm * tstepA; const char* cB = (const char*)g.Bt + (size_t)cur.pn * tstepB;
    if constexpr (SP2) {
        PG8_STAGE(PG8_SB(0, 0), cB, voffB); PG8_STAGE(PG8_SB(0, 1), cB + hstepB, voffB); PG8_STAGE(PG8_SA(0, 0), cA, voffA); PG8_STAGE(PG8_SA(0, 1), cA + hstepA, voffA);
        if (wr == 1) PG8_BAR;
        PG8_WAIT_V(2); PG8_BAR;
        PG8_STAGE(PG8_SB(1, 0), cB + kstep, voffB); PG8_STAGE(PG8_SA(1, 0), cA + kstep, voffA); PG8_STAGE(PG8_SB(1, 1), cB + hstepB + kstep, voffB);
        PG8_WAIT_V(6); PG8_BAR;
    } else {
    PG8_STAGE(PG8_SB(0, 0), cB, voffB); PG8_STAGE(PG8_SA(0, 0), cA, voffA); PG8_STAGE(PG8_SB(0, 1), cB + hstepB, voffB); PG8_STAGE(PG8_SA(0, 1), cA + hstepA, voffA);
    if (wr == 1) PG8_BAR;
    PG8_WAIT_V(4); PG8_BAR;
    PG8_STAGE(PG8_SB(1, 0), cB + kstep, voffB); PG8_STAGE(PG8_SA(1, 0), cA + kstep, voffA); PG8_STAGE(PG8_SB(1, 1), cB + hstepB + kstep, voffB);
    PG8_WAIT_V(6); PG8_BAR;
    }
    for (;;) {
        const bool has_next = S.next(ui + 1, nxt);
        const char* nA = has_next ? (const char*)g.A + (size_t)nxt.pm * tstepA : cA; const char* nB = has_next ? (const char*)g.Bt + (size_t)nxt.pn * tstepB : cB;
        for (int t = 0; t < nt; t += 2) {
            const bool last = (t == nt - 2);
            const char* a1 = PG8_ATILE(cA, t + 1);
            const char* a2 = last ? nA : PG8_ATILE(cA, t + 2); const char* b2 = last ? nB : cB + (size_t)(t + 2) * kstep;
            const char* a3 = a2 + kstep; const char* b3 = b2 + kstep;
            if constexpr (SP2) {
            PG8_LDB(B0, 0, 0); PG8_LDB(B1, 0, 1); PG8_SCHED; PG8_LDA(At, 0, 0); PG8_STAGE(PG8_SA(1, 1), a1 + hstepA, voffA);
            PG8_WAIT_V(8); PG8_WAIT_L(0); PG8_BAR; PG8_MMA(0, 0, At, B0); PG8_MMA(0, 1, At, B1); PG8_BAR; PG8_SCHED;
            PG8_LDA(At, 0, 1); PG8_STAGE(PG8_SB(0, 0), b2, voffB); PG8_STAGE(PG8_SB(0, 1), b2 + hstepB, voffB); PG8_STAGE(PG8_SA(0, 0), a2, voffA);
            PG8_WAIT_V(8); PG8_WAIT_L(0); PG8_BAR; PG8_MMA(1, 0, At, B0); PG8_MMA(1, 1, At, B1); PG8_BAR; PG8_SCHED;
            PG8_LDB(B0, 1, 0); PG8_LDB(B1, 1, 1); PG8_SCHED; PG8_LDA(At, 1, 0); PG8_STAGE(PG8_SA(0, 1), a2 + hstepA, voffA);
            PG8_WAIT_V(8); PG8_WAIT_L(0); PG8_BAR; PG8_MMA(0, 0, At, B0); PG8_MMA(0, 1, At, B1); PG8_BAR; PG8_SCHED;
            PG8_LDA(At, 1, 1); PG8_STAGE(PG8_SB(1, 0), b3, voffB); PG8_STAGE(PG8_SB(1, 1), b3 + hstepB, voffB); PG8_STAGE(PG8_SA(1, 0), a3, voffA);
            PG8_WAIT_V(8); PG8_WAIT_L(0); PG8_BAR; PG8_MMA(1, 0, At, B0); PG8_MMA(1, 1, At, B1); PG8_BAR; PG8_SCHED;
            } else {
            PG8_LDB(B0, 0, 0); PG8_SCHED; PG8_LDA(At, 0, 0); PG8_STAGE(PG8_SA(1, 1), a1 + hstepA, voffA);
            PG8_WAIT_L(8); PG8_BAR; PG8_WAIT_L(0); PG8_MMA(0, 0, At, B0); PG8_BAR; PG8_SCHED;
            PG8_LDB(B1, 0, 1); PG8_STAGE(PG8_SB(0, 0), b2, voffB);
            PG8_BAR; PG8_WAIT_L(0); PG8_MMA(0, 1, At, B1); PG8_BAR;
            PG8_LDA(At, 0, 1); PG8_STAGE(PG8_SA(0, 0), a2, voffA);
            PG8_BAR; PG8_WAIT_L(0); PG8_MMA(1, 0, At, B0); PG8_BAR; PG8_SCHED;
            PG8_STAGE(PG8_SB(0, 1), b2 + hstepB, voffB);
            PG8_WAIT_V(6); PG8_BAR; PG8_MMA(1, 1, At, B1); PG8_BAR;
            PG8_LDB(B0, 1, 0); PG8_SCHED; PG8_LDA(At, 1, 0); PG8_STAGE(PG8_SA(0, 1), a2 + hstepA, voffA);
            PG8_WAIT_L(8); PG8_BAR; PG8_WAIT_L(0); PG8_MMA(0, 0, At, B0); PG8_BAR; PG8_SCHED;
            PG8_LDB(B1, 1, 1); PG8_STAGE(PG8_SB(1, 0), b3, voffB);
            PG8_BAR; PG8_WAIT_L(0); PG8_MMA(0, 1, At, B1); PG8_BAR;
            PG8_LDA(At, 1, 1); PG8_STAGE(PG8_SA(1, 0), a3, voffA);
            PG8_BAR; PG8_WAIT_L(0); PG8_MMA(1, 0, At, B0); PG8_BAR; PG8_SCHED;
            PG8_STAGE(PG8_SB(1, 1), b3 + hstepB, voffB);
            PG8_WAIT_V(6); PG8_BAR; PG8_MMA(1, 1, At, B1); PG8_BAR;
            }
        }
        if constexpr (ALIGN_EPI) { if (wr == 0) PG8_BAR; }
        E(acc, cur, wr, wc, fr, fq);
        if (!has_next) break;
#pragma unroll
        for (int a = 0; a < 2; ++a)
#pragma unroll
            for (int b = 0; b < 2; ++b)
#pragma unroll
                for (int m = 0; m < 4; ++m)
#pragma unroll
                    for (int n = 0; n < 2; ++n) acc[a][b][m][n] = (f32x4){0.f, 0.f, 0.f, 0.f};
        cur = nxt; cA = nA; cB = nB; ++ui;
        if constexpr (ALIGN_EPI) { if (wr == 1) PG8_BAR; }
    }
    PG8_WAIT_V(0);
    if constexpr (!ALIGN_EPI) { if (wr == 0) PG8_BAR; }
    PG8_BAR;
#undef PG8_SA
#undef PG8_SB
#undef PG8_STAGE
#undef PG8_LDA
#undef PG8_LDB
#undef PG8_MMA
#undef PG8_WAIT_V
#undef PG8_WAIT_L
#undef PG8_BAR
#undef PG8_SCHED
#undef PG8_ATILE
}
}

typedef unsigned short bf16_t;
#define LAS __attribute__((address_space(3)))
constexpr int NT = 512;
constexpr int T_TOK = 32768, SEQ = 4096, NB = 8, DM = 1024, PLE = 256;
constexpr size_t MiB = (size_t)1 << 20;
constexpr size_t WS_U = 0, WS_PROJ = 64 * MiB, WS_T1 = WS_PROJ, WS_E = WS_PROJ + 128 * MiB, WS_YA = 320 * MiB, WS_YB = 384 * MiB,
                 WS_WIN = 448 * MiB, WS_WOUT = 464 * MiB, WS_PPROJ = 468 * MiB, WS_PGATE = 469 * MiB, WS_PB = 472 * MiB, WS_A3 = 488 * MiB, WS_CTL = 490 * MiB, WS_END = 491 * MiB;
constexpr int LDS_BYTES = 144 * 1024 + 16;
constexpr float RMS_EPS = 1e-6f;

struct Params { const float* in[22]; float* out; unsigned char* ws; int ph_lo, ph_hi; };

__device__ __forceinline__ int otid() { int t = threadIdx.x; asm volatile("" : "+v"(t)); return t; }
typedef unsigned ntu4_t __attribute__((ext_vector_type(4)));
typedef float ntf4_t __attribute__((ext_vector_type(4)));
__device__ __forceinline__ uint4 ntld_u4(const void* p) { const ntu4_t v = __builtin_nontemporal_load((const ntu4_t*)p); return make_uint4(v.x, v.y, v.z, v.w); }
__device__ __forceinline__ float4 ntld_f4(const void* p) { const ntf4_t v = __builtin_nontemporal_load((const ntf4_t*)p); return make_float4(v.x, v.y, v.z, v.w); }
__device__ __forceinline__ float bf2f(bf16_t b) { return __uint_as_float(((unsigned)b) << 16); }
__device__ __forceinline__ bf16_t f2bf(float f) { unsigned u = __float_as_uint(f); u += 0x7FFFu + ((u >> 16) & 1u); return (bf16_t)(u >> 16); }
__device__ __forceinline__ int olane() { int l = __builtin_amdgcn_mbcnt_hi(-1, __builtin_amdgcn_mbcnt_lo(-1, 0)); asm volatile("" : "+v"(l)); return l; }
__device__ __forceinline__ float bperm_f(int addr, float v) { return __uint_as_float((unsigned)__builtin_amdgcn_ds_bpermute(addr, (int)__float_as_uint(v))); }
__device__ __forceinline__ float wave_sum(float v) { const int l = olane();
#pragma unroll
    for (int o = 32; o >= 1; o >>= 1) v += bperm_f((l ^ o) << 2, v);
    return v; }
__device__ __forceinline__ float wave_max(float v) { const int l = olane();
#pragma unroll
    for (int o = 32; o >= 1; o >>= 1) v = fmaxf(v, bperm_f((l ^ o) << 2, v));
    return v; }
__device__ __forceinline__ float silu(float x) { return x * __builtin_amdgcn_rcpf(1.0f + __expf(-x)); }

__device__ void ph_rmsnorm_rows(const float* __restrict__ hin, const float* __restrict__ g, bf16_t* __restrict__ out) {
    const int tid = otid(); const int lane = tid & 63, wid = tid >> 6;
    for (int row = blockIdx.x * 8 + wid; row < T_TOK; row += gridDim.x * 8) {
        const float4* src = (const float4*)(hin + (size_t)row * DM);
        float4 v[4]; float ss = 0.f;
#pragma unroll
        for (int i = 0; i < 4; ++i) { v[i] = ntld_f4(src + lane + 64 * i); ss += v[i].x * v[i].x + v[i].y * v[i].y + v[i].z * v[i].z + v[i].w * v[i].w; }
        ss = wave_sum(ss);
        const float r = rsqrtf(ss * (1.0f / DM) + RMS_EPS);
#pragma unroll
        for (int i = 0; i < 4; ++i) { const float4 gv = ((const float4*)g)[lane + 64 * i];
            uint2 w; w.x = pg8::cvt_pk_bf16(v[i].x * r * gv.x, v[i].y * r * gv.y); w.y = pg8::cvt_pk_bf16(v[i].z * r * gv.z, v[i].w * r * gv.w);
            *(uint2*)(out + (size_t)row * DM + (lane + 64 * i) * 4) = w; }
    }
}
__device__ void ph_rmsnorm_rows_b16(const bf16_t* __restrict__ hb, const float* __restrict__ g, bf16_t* __restrict__ out) {
    const int tid = otid(); const int lane = tid & 63, wid = tid >> 6;
    for (int row = blockIdx.x * 8 + wid; row < T_TOK; row += gridDim.x * 8) {
        const size_t ro = (size_t)row * DM; uint4 w[2]; float v[2][8]; float ss = 0.f;
#pragma unroll
        for (int i = 0; i < 2; ++i) w[i] = ntld_u4(hb + ro + (lane + 64 * i) * 8);
#pragma unroll
        for (int i = 0; i < 2; ++i) { const unsigned ww[4] = {w[i].x, w[i].y, w[i].z, w[i].w};
#pragma unroll
            for (int k = 0; k < 4; ++k) { v[i][2 * k] = __uint_as_float(ww[k] << 16); v[i][2 * k + 1] = __uint_as_float(ww[k] & 0xffff0000u); ss += v[i][2 * k] * v[i][2 * k] + v[i][2 * k + 1] * v[i][2 * k + 1]; } }
        ss = wave_sum(ss);
        const float r = rsqrtf(ss * (1.0f / DM) + RMS_EPS);
        float4 gaa[2], gbb[2];
#pragma unroll
        for (int i = 0; i < 2; ++i) { const int e0 = (lane + 64 * i) * 8; gaa[i] = *(const float4*)(g + e0); gbb[i] = *(const float4*)(g + e0 + 4); }
#pragma unroll
        for (int i = 0; i < 2; ++i) { const int e0 = (lane + 64 * i) * 8; const float4 ga = gaa[i], gb = gbb[i];
            uint4 o; o.x = pg8::cvt_pk_bf16(v[i][0] * r * ga.x, v[i][1] * r * ga.y); o.y = pg8::cvt_pk_bf16(v[i][2] * r * ga.z, v[i][3] * r * ga.w);
            o.z = pg8::cvt_pk_bf16(v[i][4] * r * gb.x, v[i][5] * r * gb.y); o.w = pg8::cvt_pk_bf16(v[i][6] * r * gb.z, v[i][7] * r * gb.w);
            *(uint4*)(out + ro + e0) = o; }
    }
}
__device__ void prep_tile(const float* __restrict__ src, int srcld, bf16_t* __restrict__ dst, int K, int n0, int srccol0, int k0, float* sl) {
    const int tid = otid();
#pragma unroll
    for (int i = 0; i < 2; ++i) { const int idx = tid + NT * i, kk = idx >> 4, c4 = idx & 15;
        const float4 v = ntld_f4(src + (size_t)(k0 + kk) * srcld + srccol0 + c4 * 4);
        float* d = sl + kk * 65 + c4 * 4; d[0] = v.x; d[1] = v.y; d[2] = v.z; d[3] = v.w; }
    __syncthreads();
    { const int n = tid >> 3, kg = tid & 7; float f[8];
#pragma unroll
      for (int j = 0; j < 8; ++j) f[j] = sl[(kg * 8 + j) * 65 + n];
      uint4 w; w.x = pg8::cvt_pk_bf16(f[0], f[1]); w.y = pg8::cvt_pk_bf16(f[2], f[3]); w.z = pg8::cvt_pk_bf16(f[4], f[5]); w.w = pg8::cvt_pk_bf16(f[6], f[7]);
      *(uint4*)(dst + (size_t)(n0 + n) * K + k0 + kg * 8) = w; }
    __syncthreads();
}
__device__ void ph_prep_weights(const Params& P, int layer, float* sl) {
    unsigned char* ws = P.ws;
    const bool odd = (layer & 1);
    for (int t = blockIdx.x; t < 2880; t += gridDim.x) {
        if (t < 2048) { const int nt_ = t >> 4, kt = t & 15, n0 = nt_ * 64; int sc = n0;
            if (odd) { const int half = n0 >> 12, j = n0 & 4095; sc = (j >> 10) * 2048 + half * 1024 + (j & 1023); }
            prep_tile(P.in[2] + (size_t)layer * 1024 * 8192, 8192, (bf16_t*)(ws + WS_WIN), 1024, n0, sc, kt * 64, sl); }
        else if (t < 2560) { const int q = t - 2048, nt_ = q >> 5, kt = q & 31;
            prep_tile(P.in[3] + (size_t)layer * 2048 * 1024, 1024, (bf16_t*)(ws + WS_WOUT), 2048, nt_ * 64, nt_ * 64, kt * 64, sl); }
        else if (t < 2624) { const int q = t - 2560, nt_ = q >> 2, kt = q & 3;
            prep_tile(P.in[19] + (size_t)layer * 256 * 1024, 1024, (bf16_t*)(ws + WS_PPROJ), 256, nt_ * 64, nt_ * 64, kt * 64, sl); }
        else { const int q = t - 2624, nt_ = q >> 4, kt = q & 15;
            prep_tile(P.in[21] + (size_t)layer * 1024 * 1024, 1024, (bf16_t*)(ws + WS_PGATE), 1024, nt_ * 64, nt_ * 64, kt * 64, sl); }
    }
}
__device__ void ph_convert_p(const float* __restrict__ p, bf16_t* __restrict__ pb) {
    const size_t n4 = (size_t)T_TOK * PLE / 4;
    for (size_t i = (size_t)blockIdx.x * NT + otid(); i < n4; i += (size_t)gridDim.x * NT) {
        const float4 v = ntld_f4(((const float4*)p) + i); uint2 w; w.x = pg8::cvt_pk_bf16(v.x, v.y); w.y = pg8::cvt_pk_bf16(v.z, v.w); ((uint2*)pb)[i] = w; }
}
__device__ void ph_filter_mlp(const Params& P, int j, float* __restrict__ a3) {
    const int tid = otid(); const int lane = tid & 63, wid = tid >> 6;
    const float* w1 = P.in[8] + (size_t)j * 33 * 64; const float* b1 = P.in[9] + j * 64;
    const float* w2 = P.in[10] + (size_t)j * 64 * 64; const float* b2 = P.in[11] + j * 64;
    const float* w3 = P.in[12] + (size_t)j * 64 * 64; const float* b3 = P.in[13] + j * 64;
    const float fq = P.in[15][j * 64 + lane];
    for (int pos = blockIdx.x * 8 + wid; pos < SEQ; pos += gridDim.x * 8) {
        float z = 0.f;
        const float wpos = (float)(2.0 * 3.14159265358979323846 / SEQ) * (float)pos;
        if (lane == 0) z = (float)pos / (float)(SEQ - 1);
        else if (lane <= 16) { const float fr = 1e-4f + (float)(lane - 1) * ((15.0f - 1e-4f) / 15.0f); z = cosf(fr * wpos); }
        else if (lane <= 32) { const float fr = 1e-4f + (float)(lane - 17) * ((15.0f - 1e-4f) / 15.0f); z = -sinf(fr * wpos); }
        float acc = b1[lane];
        for (int i = 0; i < 33; ++i) acc += __shfl(z, i) * w1[i * 64 + lane];
        float a = sinf(fq * acc);
        acc = b2[lane];
        for (int i = 0; i < 64; ++i) acc += __shfl(a, i) * w2[i * 64 + lane];
        a = sinf(fq * acc);
        acc = b3[lane];
        for (int i = 0; i < 64; ++i) acc += __shfl(a, i) * w3[i * 64 + lane];
        a = sinf(fq * acc);
        a3[pos * 64 + lane] = a;
    }
}
__device__ void ph_filter_gen(const Params& P, int j, const float* __restrict__ a3, float* __restrict__ kf, float* sl) {
    const int tid = otid(), lane = tid & 63, wid = tid >> 6;
    const float* w4 = P.in[14] + (size_t)j * 64 * 4096;
    float* sw = sl; float* red = sl + 256;
    const float min_decay = logf(1e-2f) / 1.5f, max_decay = logf(1e-2f) / 0.3f;
    for (int c = blockIdx.x; c < 1024; c += gridDim.x) {
        if (tid < 256) { const int jj = tid >> 2, q = tid & 3; sw[tid] = w4[(size_t)jj * 4096 + q * 1024 + c]; }
        __syncthreads();
        const float delta = fabsf(min_decay + (float)c * ((max_decay - min_decay) / 1023.0f));
        float hv[8][4]; float n0 = 0.f, n1 = 0.f;
#pragma unroll
        for (int i = 0; i < 8; ++i) { const int t = tid + NT * i; const float4* ar = (const float4*)(a3 + (size_t)t * 64);
            float a0 = 0.f, a1 = 0.f, a2 = 0.f, a3v = 0.f;
#pragma unroll 4
            for (int jq = 0; jq < 16; ++jq) { const float4 av = ar[jq]; const float ae[4] = {av.x, av.y, av.z, av.w};
#pragma unroll
                for (int e = 0; e < 4; ++e) { const float4 wv = *(const float4*)(sw + (jq * 4 + e) * 4); a0 += ae[e] * wv.x; a1 += ae[e] * wv.y; a2 += ae[e] * wv.z; a3v += ae[e] * wv.w; } }
            const float dec = expf(-((float)t / (float)(SEQ - 1)) * delta);
            hv[i][0] = a0 * dec; hv[i][1] = a1 * dec; hv[i][2] = a2 * dec; hv[i][3] = a3v * dec;
            n0 += fabsf(hv[i][0]) + (t >= 1 ? fabsf(hv[i][1]) : 0.f); n1 += fabsf(hv[i][2]) + (t >= 1 ? fabsf(hv[i][3]) : 0.f); }
        n0 = wave_sum(n0); n1 = wave_sum(n1);
        if (lane == 0) { red[wid * 2] = n0; red[wid * 2 + 1] = n1; }
        __syncthreads();
        float s0 = 0.f, s1 = 0.f;
#pragma unroll
        for (int w = 0; w < 8; ++w) { s0 += red[w * 2]; s1 += red[w * 2 + 1]; }
        const float i0 = 1.0f / s0, i1 = 1.0f / s1;
        float* k0 = kf + (size_t)c * 8192; float* k1 = kf + (size_t)(1024 + c) * 8192;
#pragma unroll
        for (int i = 0; i < 8; ++i) { const int t = tid + NT * i;
            k0[t] = hv[i][0] * i0; k1[t] = hv[i][2] * i1;
            if (t >= 1) { k0[8192 - t] = hv[i][1] * i0; k1[8192 - t] = hv[i][3] * i1; } }
        if (tid == 0) { k0[4096] = 0.f; k1[4096] = 0.f; }
        __syncthreads();
    }
}

__device__ __forceinline__ float sconv(const bf16_t* row, int t, float w0, float w1, float w2, float b) {
    const float xm = t > 0 ? bf2f(row[t - 1]) : 0.f, x0 = bf2f(row[t]), xp = t < SEQ - 1 ? bf2f(row[t + 1]) : 0.f;
    return w0 * xm + w1 * x0 + w2 * xp + b; }
__device__ void ph_hyena_naive(const Params& P, int j, const bf16_t* __restrict__ projAT, const float* __restrict__ kf, bf16_t* __restrict__ yaT, float* sl) {
    const int tid = otid();
    float* sv = sl; float* sk = sl + 4096; float* sz = sk + 8192;
    const float* cw = P.in[6] + (size_t)j * 3 * 3072; const float* cb = P.in[7] + (size_t)j * 3072; const float* skip = P.in[16] + (size_t)j * 2 * 1024;
    for (int unit = blockIdx.x; unit < 8192; unit += gridDim.x) {
        const int c = unit >> 3, b = unit & 7;
        const bf16_t* vrow = projAT + (size_t)c * T_TOK + b * SEQ; const bf16_t* x1row = projAT + (size_t)(1024 + c) * T_TOK + b * SEQ;
        const bf16_t* x2row = projAT + (size_t)(2048 + c) * T_TOK + b * SEQ; const bf16_t* grow = projAT + (size_t)(3072 + c) * T_TOK + b * SEQ;
        const float wv0 = cw[c], wv1 = cw[3072 + c], wv2 = cw[6144 + c], bv = cb[c];
        const float wa0 = cw[1024 + c], wa1 = cw[3072 + 1024 + c], wa2 = cw[6144 + 1024 + c], ba = cb[1024 + c];
        const float wb0 = cw[2048 + c], wb1 = cw[3072 + 2048 + c], wb2 = cw[6144 + 2048 + c], bb = cb[2048 + c];
        const float sk0 = skip[c], sk1 = skip[1024 + c];
        for (int t = tid; t < SEQ; t += NT) sv[t] = sconv(vrow, t, wv0, wv1, wv2, bv);
        for (int i = tid; i < 8192; i += NT) sk[i] = kf[(size_t)c * 8192 + i];
        __syncthreads();
        float acc[8];
#pragma unroll
        for (int i = 0; i < 8; ++i) acc[i] = 0.f;
        for (int s = 0; s < SEQ; ++s) { const float vs = sv[s];
#pragma unroll
            for (int i = 0; i < 8; ++i) acc[i] += vs * sk[(tid + NT * i - s) & 8191]; }
#pragma unroll
        for (int i = 0; i < 8; ++i) { const int t = tid + NT * i; sz[t] = sconv(x1row, t, wa0, wa1, wa2, ba) * (acc[i] + sk0 * sv[t]); }
        __syncthreads();
        for (int i = tid; i < 8192; i += NT) sk[i] = kf[(size_t)(1024 + c) * 8192 + i];
        __syncthreads();
#pragma unroll
        for (int i = 0; i < 8; ++i) acc[i] = 0.f;
        for (int s = 0; s < SEQ; ++s) { const float vs = sz[s];
#pragma unroll
            for (int i = 0; i < 8; ++i) acc[i] += vs * sk[(tid + NT * i - s) & 8191]; }
#pragma unroll
        for (int i = 0; i < 8; ++i) { const int t = tid + NT * i;
            const float y = sconv(x2row, t, wb0, wb1, wb2, bb) * (acc[i] + sk1 * sz[t]) * silu(bf2f(grow[t]));
            yaT[(size_t)c * T_TOK + b * SEQ + t] = f2bf(y); }
        __syncthreads();
    }
}

struct cf { float x, y; };
__device__ __forceinline__ cf cmul(cf a, cf b) { return cf{a.x * b.x - a.y * b.y, a.x * b.y + a.y * b.x}; }
__device__ __forceinline__ cf cmulc(cf a, cf b) { return cf{a.x * b.x + a.y * b.y, a.y * b.x - a.x * b.y}; }
__device__ __forceinline__ constexpr float c16(int k) { constexpr float t[8] = {1.0f, 0.92387953251128674f, 0.70710678118654752f, 0.38268343236508977f, 0.0f, -0.38268343236508977f, -0.70710678118654752f, -0.92387953251128674f}; return t[k]; }
__device__ __forceinline__ constexpr float s16(int k) { constexpr float t[8] = {0.0f, 0.38268343236508977f, 0.70710678118654752f, 0.92387953251128674f, 1.0f, 0.92387953251128674f, 0.70710678118654752f, 0.38268343236508977f}; return t[k]; }
__device__ __forceinline__ cf twc(cf ws, int k16) { if (k16 == 0) return ws; if (k16 == 4) return cf{ws.y, -ws.x}; return cmul(ws, cf{c16(k16), -s16(k16)}); }
template <int LR> __device__ __forceinline__ void dif_reg(cf (&x)[1 << LR], cf w) {
    constexpr int R = 1 << LR; cf ws = w;
#pragma unroll
    for (int s = 0; s < LR; ++s) { const int half = R >> (s + 1);
#pragma unroll
        for (int m0 = 0; m0 < R; m0 += 2 * half)
#pragma unroll
            for (int mm = 0; mm < half; ++mm) { const int ia = m0 + mm, ib = ia + half; const cf a = x[ia], b = x[ib];
                x[ia] = cf{a.x + b.x, a.y + b.y}; const cf d{a.x - b.x, a.y - b.y};
                x[ib] = cmul(d, twc(ws, (mm << s) * (16 / R))); }
        ws = cmul(ws, ws); }
}
template <int LR> __device__ __forceinline__ void dit_reg(cf (&x)[1 << LR], cf w) {
    constexpr int R = 1 << LR; cf wsv[LR]; wsv[0] = w;
#pragma unroll
    for (int s = 1; s < LR; ++s) wsv[s] = cmul(wsv[s - 1], wsv[s - 1]);
#pragma unroll
    for (int s = LR - 1; s >= 0; --s) { const int half = R >> (s + 1);
#pragma unroll
        for (int m0 = 0; m0 < R; m0 += 2 * half)
#pragma unroll
            for (int mm = 0; mm < half; ++mm) { const int ia = m0 + mm, ib = ia + half; const cf a = x[ia];
                const cf b = cmulc(x[ib], twc(wsv[s], (mm << s) * (16 / R)));
                x[ia] = cf{a.x + b.x, a.y + b.y}; x[ib] = cf{a.x - b.x, a.y - b.y}; } }
}
typedef float v2f __attribute__((ext_vector_type(2)));
__device__ __forceinline__ v2f mkv2(float a, float b) { v2f r; r.x = a; r.y = b; return r; }
typedef LAS v2f* ldsf2;
__device__ __forceinline__ void lds_barrier() { asm volatile("s_waitcnt lgkmcnt(0)\n\ts_barrier" ::: "memory"); }
template <int LR, bool INV> __device__ __forceinline__ void fft_pass(ldsf2 buf, int base, int stride, int twi) {
    constexpr int R = 1 << LR; cf x[R];
    const v2f wv = ((ldsf2)((LAS unsigned char*)buf + 139264))[twi];
#pragma unroll
    for (int m = 0; m < R; ++m) { const v2f v = buf[base + m * stride]; x[m] = cf{v.x, v.y}; }
    const cf w{wv.x, wv.y};
    if (INV) dit_reg<LR>(x, w); else dif_reg<LR>(x, w);
#pragma unroll
    for (int m = 0; m < R; ++m) buf[base + m * stride] = mkv2(x[m].x, x[m].y);
}
__device__ __forceinline__ void wave_lds_fence() { asm volatile("s_waitcnt lgkmcnt(0)" ::: "memory"); }
__device__ __forceinline__ void fft_fwd_abc(ldsf2 buf) {
    const int tid = otid(); const int wv = tid >> 6, l = tid & 63;
#pragma unroll 1
    for (int u = 0; u < 2; ++u) { const int bf = tid + NT * u; fft_pass<3, false>(buf, bf + (bf >> 4), 1088, bf); }
    lds_barrier();
#pragma unroll 1
    for (int u = 0; u < 2; ++u) { const int o = l + 64 * u, e0 = wv * 1024 + o; fft_pass<3, false>(buf, e0 + (e0 >> 4), 136, o * 8); }
    wave_lds_fence();
#pragma unroll 1
    for (int u = 0; u < 2; ++u) { const int j = l + 64 * u, o = j & 15, e0 = wv * 1024 + (j >> 4) * 128 + o; fft_pass<3, false>(buf, e0 + (e0 >> 4), 17, o * 64); }
    wave_lds_fence();
}
__device__ __forceinline__ void fft_inv_cba(ldsf2 buf) {
    const int tid = otid(); const int wv = tid >> 6, l = tid & 63;
#pragma unroll 1
    for (int u = 0; u < 2; ++u) { const int j = l + 64 * u, o = j & 15, e0 = wv * 1024 + (j >> 4) * 128 + o; fft_pass<3, true>(buf, e0 + (e0 >> 4), 17, o * 64); }
    wave_lds_fence();
#pragma unroll 1
    for (int u = 0; u < 2; ++u) { const int o = l + 64 * u, e0 = wv * 1024 + o; fft_pass<3, true>(buf, e0 + (e0 >> 4), 136, o * 8); }
    lds_barrier();
#pragma unroll 1
    for (int u = 0; u < 2; ++u) { const int bf = tid + NT * u; fft_pass<3, true>(buf, bf + (bf >> 4), 1088, bf); }
    lds_barrier();
}
typedef _Float16 h2_t __attribute__((ext_vector_type(2)));
__device__ __forceinline__ void make_spec(ldsf2 buf, LAS unsigned* spec, const float* __restrict__ kfrow) {
    const int tid = otid();
#pragma unroll
    for (int q = 0; q < 4; ++q) { const float4 v = *(const float4*)(kfrow + tid * 16 + q * 4);
        buf[tid * 17 + q * 4 + 0] = mkv2(v.x, 0.f); buf[tid * 17 + q * 4 + 1] = mkv2(v.y, 0.f); buf[tid * 17 + q * 4 + 2] = mkv2(v.z, 0.f); buf[tid * 17 + q * 4 + 3] = mkv2(v.w, 0.f); }
    __syncthreads();
    fft_fwd_abc(buf);
    cf x[16];
#pragma unroll
    for (int m = 0; m < 16; ++m) { const v2f v = buf[tid * 17 + m]; x[m] = cf{v.x, v.y}; }
    dif_reg<4>(x, cf{1.0f, 0.0f});
#pragma unroll
    for (int m = 0; m < 16; ++m) { h2_t hv; hv.x = (_Float16)x[m].x; hv.y = (_Float16)x[m].y; spec[tid * 17 + m] = __builtin_bit_cast(unsigned, hv); }
    lds_barrier();
}
__device__ __forceinline__ void fft_conv(ldsf2 buf, const LAS unsigned* spec) {
    fft_fwd_abc(buf);
    { const int tid = otid(); cf x[16];
#pragma unroll
      for (int m = 0; m < 16; ++m) { const v2f v = buf[tid * 17 + m]; x[m] = cf{v.x, v.y}; }
      dif_reg<4>(x, cf{1.0f, 0.0f});
#pragma unroll
      for (int m = 0; m < 16; ++m) { const h2_t hv = __builtin_bit_cast(h2_t, spec[tid * 17 + m]); x[m] = cmul(x[m], cf{(float)hv.x, (float)hv.y}); }
      dit_reg<4>(x, cf{1.0f, 0.0f});
#pragma unroll
      for (int m = 0; m < 16; ++m) buf[tid * 17 + m] = mkv2(x[m].x, x[m].y); }
    wave_lds_fence();
    fft_inv_cba(buf);
}
struct Raw8 { uint4 body; unsigned short eL, eR; };
__device__ __forceinline__ Raw8 load_raw8(const bf16_t* __restrict__ row, int n0) {
    Raw8 r; r.body = ntld_u4(row + n0); r.eL = row[n0 > 0 ? n0 - 1 : 0]; r.eR = row[n0 + 8 < SEQ ? n0 + 8 : SEQ - 1]; return r; }
__device__ __forceinline__ void sconv8(const Raw8& r, int n0, float w0, float w1, float w2, float b, float (&out)[8]) {
    float a[10]; a[0] = n0 > 0 ? bf2f(r.eL) : 0.f; a[9] = n0 + 8 < SEQ ? bf2f(r.eR) : 0.f;
    a[1] = __uint_as_float(r.body.x << 16); a[2] = __uint_as_float(r.body.x & 0xffff0000u); a[3] = __uint_as_float(r.body.y << 16); a[4] = __uint_as_float(r.body.y & 0xffff0000u);
    a[5] = __uint_as_float(r.body.z << 16); a[6] = __uint_as_float(r.body.z & 0xffff0000u); a[7] = __uint_as_float(r.body.w << 16); a[8] = __uint_as_float(r.body.w & 0xffff0000u);
#pragma unroll
    for (int k = 0; k < 8; ++k) out[k] = w0 * a[k] + w1 * a[k + 1] + w2 * a[k + 2] + b;
}
__device__ void ph_hyena_fft(const Params& P, int j, const bf16_t* __restrict__ projAT, const float* __restrict__ kf, bf16_t* __restrict__ yaT, unsigned char* lds_raw) {
    const int tid = otid();
    ldsf2 buf = (ldsf2)lds_raw; LAS unsigned* spec1 = (LAS unsigned*)(lds_raw + 69632); LAS unsigned* spec2 = spec1 + 8704;
    const float* cw = P.in[6] + (size_t)j * 3 * 3072; const float* cb = P.in[7] + (size_t)j * 3072; const float* skip = P.in[16] + (size_t)j * 2 * 1024;
    const float invN = 1.0f / 8192.0f;
    const int n0 = tid * 8, ph0 = n0 + (n0 >> 4);
    { ldsf2 twt = (ldsf2)((LAS unsigned char*)buf + 139264);
      for (int k = tid; k < 1024; k += NT) { float sn, cs; sincospif((float)k * (2.0f / 8192.0f), &sn, &cs); twt[k] = mkv2(cs, -sn); }
      __syncthreads(); }
#pragma unroll 1
    for (int c = blockIdx.x; c < 1024; c += gridDim.x) {
        make_spec(buf, spec1, kf + (size_t)c * 8192);
        make_spec(buf, spec2, kf + (size_t)(1024 + c) * 8192);
        const float wv0 = cw[c], wv1 = cw[3072 + c], wv2 = cw[6144 + c], bv = cb[c];
        const float wa0 = cw[1024 + c], wa1 = cw[3072 + 1024 + c], wa2 = cw[6144 + 1024 + c], ba = cb[1024 + c];
        const float wb0 = cw[2048 + c], wb1 = cw[3072 + 2048 + c], wb2 = cw[6144 + 2048 + c], bb = cb[2048 + c];
        const float sk0 = skip[c], sk1 = skip[1024 + c];
        const bf16_t* vrow = projAT + (size_t)c * T_TOK; const bf16_t* x1row = projAT + (size_t)(1024 + c) * T_TOK;
        const bf16_t* x2row = projAT + (size_t)(2048 + c) * T_TOK; const bf16_t* grow = projAT + (size_t)(3072 + c) * T_TOK;
#pragma unroll 1
        for (int bp = 0; bp < 4; ++bp) {
            const size_t o0 = (size_t)(2 * bp) * SEQ, o1 = o0 + SEQ;
            float va[8], vb[8];
            { const Raw8 r0 = load_raw8(vrow + o0, n0), r1 = load_raw8(vrow + o1, n0); sconv8(r0, n0, wv0, wv1, wv2, bv, va); sconv8(r1, n0, wv0, wv1, wv2, bv, vb); }
#pragma unroll
            for (int k = 0; k < 8; ++k) { buf[ph0 + k] = mkv2(va[k], vb[k]); buf[ph0 + 4352 + k] = mkv2(0.f, 0.f); }
            const Raw8 xa0 = load_raw8(x1row + o0, n0), xa1 = load_raw8(x1row + o1, n0);
            lds_barrier();
            fft_conv(buf, spec1);
            { float xa[8], xb[8]; sconv8(xa0, n0, wa0, wa1, wa2, ba, xa); sconv8(xa1, n0, wa0, wa1, wa2, ba, xb);
#pragma unroll
              for (int k = 0; k < 8; ++k) { const v2f y = buf[ph0 + k]; va[k] = xa[k] * (y.x * invN + sk0 * va[k]); vb[k] = xb[k] * (y.y * invN + sk0 * vb[k]);
                  buf[ph0 + k] = mkv2(va[k], vb[k]); buf[ph0 + 4352 + k] = mkv2(0.f, 0.f); } }
            const Raw8 xb0 = load_raw8(x2row + o0, n0), xb1 = load_raw8(x2row + o1, n0);
            const uint4 g0 = ntld_u4(grow + o0 + n0), g1 = ntld_u4(grow + o1 + n0);
            lds_barrier();
            fft_conv(buf, spec2);
            { float xa[8], xb[8]; sconv8(xb0, n0, wb0, wb1, wb2, bb, xa); sconv8(xb1, n0, wb0, wb1, wb2, bb, xb);
              const unsigned gw0[4] = {g0.x, g0.y, g0.z, g0.w}, gw1[4] = {g1.x, g1.y, g1.z, g1.w}; unsigned w0[4], w1[4];
#pragma unroll
              for (int k2 = 0; k2 < 4; ++k2) { const v2f ya = buf[ph0 + 2 * k2], yb = buf[ph0 + 2 * k2 + 1];
                  const float ra = xa[2 * k2] * (ya.x * invN + sk1 * va[2 * k2]) * silu(__uint_as_float(gw0[k2] << 16));
                  const float rb = xa[2 * k2 + 1] * (yb.x * invN + sk1 * va[2 * k2 + 1]) * silu(__uint_as_float(gw0[k2] & 0xffff0000u));
                  const float rc = xb[2 * k2] * (ya.y * invN + sk1 * vb[2 * k2]) * silu(__uint_as_float(gw1[k2] << 16));
                  const float rd = xb[2 * k2 + 1] * (yb.y * invN + sk1 * vb[2 * k2 + 1]) * silu(__uint_as_float(gw1[k2] & 0xffff0000u));
                  w0[k2] = (unsigned)f2bf(ra) | ((unsigned)f2bf(rb) << 16); w1[k2] = (unsigned)f2bf(rc) | ((unsigned)f2bf(rd) << 16); }
              *(uint4*)(yaT + (size_t)c * T_TOK + o0 + n0) = make_uint4(w0[0], w0[1], w0[2], w0[3]);
              *(uint4*)(yaT + (size_t)c * T_TOK + o1 + n0) = make_uint4(w1[0], w1[1], w1[2], w1[3]); }
            lds_barrier();
        }
    }
}
__device__ void ph_transpose_ya(const bf16_t* __restrict__ yaT, bf16_t* __restrict__ yA, bf16_t* sl) {
    const int tid = otid();
    const int cc = tid >> 3, t8 = tid & 7;
    int tile = blockIdx.x; if (tile >= 16 * 512) return;
    uint4 v = ntld_u4(yaT + (size_t)((tile & 15) * 64 + cc) * T_TOK + (tile >> 4) * 64 + t8 * 8);
    for (;;) {
        const int c0 = (tile & 15) * 64, t0 = (tile >> 4) * 64;
        { const bf16_t* e = (const bf16_t*)&v;
#pragma unroll
          for (int jx = 0; jx < 8; ++jx) sl[cc * 66 + t8 * 8 + jx] = e[jx]; }
        __syncthreads();
        const int tn = tile + gridDim.x; const bool more = tn < 16 * 512;
        if (more) v = ntld_u4(yaT + (size_t)((tn & 15) * 64 + cc) * T_TOK + (tn >> 4) * 64 + t8 * 8);
        { const int tt = tid >> 3, c8 = tid & 7; unsigned w[4];
#pragma unroll
          for (int jx = 0; jx < 4; ++jx) w[jx] = (unsigned)sl[(c8 * 8 + 2 * jx) * 66 + tt] | ((unsigned)sl[(c8 * 8 + 2 * jx + 1) * 66 + tt] << 16);
          *(uint4*)(yA + (size_t)(t0 + tt) * DM + c0 + c8 * 8) = make_uint4(w[0], w[1], w[2], w[3]); }
        asm volatile("s_waitcnt lgkmcnt(0)\n\ts_barrier" ::: "memory");
        if (!more) break;
        tile = tn;
    }
}

__device__ __forceinline__ float dot8(const uint4& a, const uint4& b) {
    float d = 0.f;
    const unsigned aw[4] = {a.x, a.y, a.z, a.w}, bw[4] = {b.x, b.y, b.z, b.w};
#pragma unroll
    for (int i = 0; i < 4; ++i) { d += __uint_as_float(aw[i] << 16) * __uint_as_float(bw[i] << 16); d += __uint_as_float(aw[i] & 0xffff0000u) * __uint_as_float(bw[i] & 0xffff0000u); }
    return d; }
__device__ __forceinline__ int t5_bucket(int rel) {
    const int n = rel < 0 ? -rel : rel; const int ret = rel > 0 ? 16 : 0;
    int large = 8 + (int)(logf((float)(n < 1 ? 1 : n) / 8.0f) / logf(128.0f) * 8.0f); large = large > 15 ? 15 : large;
    return ret + (n < 8 ? n : large); }

template <int NSLOT, class F>
__device__ __forceinline__ void naive_attn_one(const bf16_t* __restrict__ proj, int tq, int h, const F& f, bf16_t* __restrict__ yout, int lane) {
    const uint4* qp = (const uint4*)(proj + (size_t)tq * 4096 + h * 64);
    uint4 q[8];
#pragma unroll
    for (int i = 0; i < 8; ++i) q[i] = qp[i];
    float s[NSLOT]; int tk[NSLOT]; float mx = -1e30f;
#pragma unroll
    for (int e = 0; e < NSLOT; ++e) { int tok; float bias; f(e, lane, tok, bias); tk[e] = tok; s[e] = -1e30f;
        if (tok >= 0) { const uint4* kp = (const uint4*)(proj + (size_t)tok * 4096 + 1024 + h * 64); float d = 0.f;
#pragma unroll
            for (int i = 0; i < 8; ++i) d += dot8(q[i], kp[i]);
            s[e] = d * 0.125f + bias; }
        mx = fmaxf(mx, s[e]); }
    mx = wave_max(mx);
    float sum = 0.f;
#pragma unroll
    for (int e = 0; e < NSLOT; ++e) { const float p = tk[e] >= 0 ? __expf(s[e] - mx) : 0.f; s[e] = p; sum += p; }
    sum = wave_sum(sum);
    float o = 0.f;
#pragma unroll
    for (int e = 0; e < NSLOT; ++e) {
        for (int l = 0; l < 64; ++l) { const int t2 = __builtin_amdgcn_readlane(tk[e], l); const float p = __uint_as_float((unsigned)__builtin_amdgcn_readlane((int)__float_as_uint(s[e]), l));
            if (t2 >= 0) o += p * bf2f(proj[(size_t)t2 * 4096 + 2048 + h * 64 + lane]); } }
    o /= sum;
    const float gate = bf2f(proj[(size_t)tq * 4096 + 3072 + h * 64 + lane]);
    yout[(size_t)tq * 1024 + h * 64 + lane] = f2bf(o * silu(gate));
}
struct DilF { int t; int b; int h; const float* rel_bias;
    __device__ __forceinline__ void operator()(int e, int lane, int& tok, float& bias) const {
        const int pi = e / 3, jj = (e % 3) * 64 + lane; const int r = pi == 0 ? 1 : (pi == 1 ? 4 : 16);
        const int rel = (jj - 64) * r, tkk = t + rel;
        if (jj > 128 || tkk < 0 || tkk >= SEQ) { tok = -1; bias = 0.f; return; }
        tok = b * SEQ + tkk; bias = rel_bias[t5_bucket(rel) * 16 + h]; } };
struct NatF { int r, c, b; const float* rpb_h;
    __device__ __forceinline__ void operator()(int e, int lane, int& tok, float& bias) const {
        const int kk = e * 64 + lane, kr = kk >> 4, kc = kk & 15;
        int rs = r - 4; rs = rs < 0 ? 0 : (rs > 56 ? 56 : rs); int cs = c - 8; cs = cs < 0 ? 0 : (cs > 48 ? 48 : cs);
        tok = b * SEQ + (rs + kr) * 64 + cs + kc; bias = rpb_h[(rs + kr - r + 7) * 31 + (cs + kc - c + 15)]; } };
__device__ void ph_dilated_naive(const Params& P, const bf16_t* __restrict__ proj, bf16_t* __restrict__ yout) {
    const int tid = otid(); const int lane = tid & 63, wid = tid >> 6;
    for (int u = blockIdx.x * 8 + wid; u < T_TOK * 16; u += gridDim.x * 8) {
        const int h = u & 15, tq = u >> 4; DilF f{tq & (SEQ - 1), tq >> 12, h, P.in[17]};
        naive_attn_one<9, DilF>(proj, tq, h, f, yout, lane); }
}
__device__ void ph_natten_naive(const Params& P, int j, int half, const bf16_t* __restrict__ proj, bf16_t* __restrict__ yout) {
    const int tid = otid(); const int lane = tid & 63, wid = tid >> 6;
    const float* rpb = P.in[18] + (size_t)j * 32 * 15 * 31;
    for (int u = blockIdx.x * 8 + wid; u < T_TOK * 16; u += gridDim.x * 8) {
        const int h = u & 15, tq = u >> 4, pos = tq & (SEQ - 1); NatF f{pos >> 6, pos & 63, tq >> 12, rpb + (size_t)(half * 16 + h) * 15 * 31};
        naive_attn_one<2, NatF>(proj, tq, h, f, yout, lane); }
}


typedef float f32x16 __attribute__((ext_vector_type(16)));
typedef float f32x8v __attribute__((ext_vector_type(8)));
typedef __bf16 bf16x8n __attribute__((ext_vector_type(8)));
typedef short bf16x8s __attribute__((ext_vector_type(8)));
typedef unsigned u32x4a __attribute__((ext_vector_type(4)));
__device__ __forceinline__ int crow32(int reg, int h) { return (reg & 3) + 8 * (reg >> 2) + 4 * h; }
template <class Pol>
__device__ __forceinline__ void attn_loadk(const bf16_t* __restrict__ kbase, const Pol& pol, int fb, int r, int hh, bf16x8s (&kf)[4]) {
    const int ktr = pol.ktok(fb, r);
#pragma unroll
    for (int s = 0; s < 4; ++s) kf[s] = *(const bf16x8s*)(kbase + ktr * 64 + 16 * s + 8 * hh);
}
template <class Pol>
__device__ __forceinline__ void attn_loadv(const bf16_t* __restrict__ vbase, const Pol& pol, int fb, int r, int hh, u32x4a (&vg)[4]) {
    const int lane = hh * 32 + r;
#pragma unroll
    for (int j = 0; j < 4; ++j) { const int vt = pol.ktok(fb, 8 * j + (lane >> 3)); vg[j] = *(const u32x4a*)(vbase + vt * 64 + (lane & 7) * 8); }
}
template <class Pol>
__device__ __forceinline__ void attn_compute(const bf16_t* __restrict__ kbase, const Pol& pol, int fb, int fbn, bool first, int r, int hh, int xaddr, const bf16x8s (&qf)[4], bf16x8s (&kf)[4], u32x4a (&vg)[4], const bf16_t* __restrict__ vbase, LAS unsigned char* wl,
                                             f32x16& o0, f32x16& o1, float& m_run, float& l_run) {
    f32x16 sc;
#pragma unroll
    for (int i = 0; i < 16; ++i) sc[i] = 0.f;
#pragma unroll
    for (int s = 0; s < 4; ++s) sc = __builtin_amdgcn_mfma_f32_32x32x16_bf16(kf[s], qf[s], sc, 0, 0, 0);
    attn_loadk<Pol>(kbase, pol, fbn, r, hh, kf);
    pol.scores(fb, r, hh, sc);
    if (first) { float bm = sc[0];
#pragma unroll
        for (int i = 1; i < 16; ++i) bm = fmaxf(bm, sc[i]);
        bm = fmaxf(bm, bperm_f(xaddr, bm)); m_run = fmaxf(bm, -40.0f); }
    float psum = 0.f;
#pragma unroll
    for (int i = 0; i < 16; ++i) { const float p = __builtin_amdgcn_exp2f(sc[i] - m_run); sc[i] = p; psum += p; }
    l_run += psum;
    { const int lane = hh * 32 + r;
      asm volatile("" ::: "memory");
#pragma unroll
      for (int j = 0; j < 4; ++j) *(LAS u32x4a*)(wl + (8 * j + (lane >> 3)) * 144 + (lane & 7) * 16) = vg[j];
      asm volatile("" ::: "memory"); }
    attn_loadv<Pol>(vbase, pol, fbn, r, hh, vg);
    u32x4a va[2], vb[2];
    { const LAS unsigned short* rp = (const LAS unsigned short*)(wl + (4 * hh) * 144 + r * 2);
#pragma unroll
      for (int s = 0; s < 2; ++s)
#pragma unroll
        for (int jx = 0; jx < 4; ++jx) { const int k0 = 16 * s + 8 * ((2 * jx) >> 2) + ((2 * jx) & 3), k1 = k0 + 1;
            va[s][jx] = (unsigned)rp[k0 * 72] | ((unsigned)rp[k1 * 72] << 16); vb[s][jx] = (unsigned)rp[k0 * 72 + 32] | ((unsigned)rp[k1 * 72 + 32] << 16); } }
#pragma unroll
    for (int s = 0; s < 2; ++s) { f32x8v t;
#pragma unroll
        for (int jx = 0; jx < 8; ++jx) t[jx] = sc[8 * s + jx];
        const bf16x8s pf = __builtin_bit_cast(bf16x8s, __builtin_convertvector(t, bf16x8n));
        o0 = __builtin_amdgcn_mfma_f32_32x32x16_bf16(__builtin_bit_cast(bf16x8s, va[s]), pf, o0, 0, 0, 0);
        o1 = __builtin_amdgcn_mfma_f32_32x32x16_bf16(__builtin_bit_cast(bf16x8s, vb[s]), pf, o1, 0, 0, 0); }
}
__device__ __forceinline__ void attn_store_out(const f32x16& o0, const f32x16& o1, float inv, const bf16_t* __restrict__ gbase, int qt, bf16_t* __restrict__ yout, int b, int h, int hh) {
    uint2 gws[2][4];
#pragma unroll
    for (int dt = 0; dt < 2; ++dt)
#pragma unroll
        for (int g = 0; g < 4; ++g) gws[dt][g] = *(const uint2*)(gbase + qt * 64 + dt * 32 + 8 * g + 4 * hh);
#pragma unroll
    for (int dt = 0; dt < 2; ++dt)
#pragma unroll
        for (int g = 0; g < 4; ++g) { const int d0 = dt * 32 + 8 * g + 4 * hh;
            const uint2 gw = gws[dt][g];
            const float g0 = __uint_as_float(gw.x << 16), g1 = __uint_as_float(gw.x & 0xffff0000u), g2 = __uint_as_float(gw.y << 16), g3 = __uint_as_float(gw.y & 0xffff0000u);
            const float v0 = (dt ? o1[4 * g] : o0[4 * g]) * inv, v1 = (dt ? o1[4 * g + 1] : o0[4 * g + 1]) * inv, v2 = (dt ? o1[4 * g + 2] : o0[4 * g + 2]) * inv, v3 = (dt ? o1[4 * g + 3] : o0[4 * g + 3]) * inv;
            uint2 w; w.x = (unsigned)f2bf(v0 * silu(g0)) | ((unsigned)f2bf(v1 * silu(g1)) << 16); w.y = (unsigned)f2bf(v2 * silu(g2)) | ((unsigned)f2bf(v3 * silu(g3)) << 16);
            *(uint2*)(yout + (size_t)(b * SEQ + qt) * 1024 + h * 64 + d0) = w; }
}
template <class Pol, int MODE>
__device__ __forceinline__ void attn_wave_task(const bf16_t* __restrict__ proj, int b, int h, Pol pol, bf16_t* __restrict__ yout, int lane, float* __restrict__ X, LAS unsigned char* wl) {
    const int r = lane & 31, hh = lane >> 5, xaddr = (lane ^ 32) << 2;
    pol.init(r, hh);
    const int qt = pol.qtok(r);
    const bf16_t* qbase = proj + (size_t)(b * 16 + h) * (4096 * 64); const bf16_t* kbase = qbase + (size_t)T_TOK * 1024; const bf16_t* vbase = kbase + (size_t)T_TOK * 1024; const bf16_t* gbase = vbase + (size_t)T_TOK * 1024;
    bf16x8s qf[4];
#pragma unroll
    for (int s = 0; s < 4; ++s) qf[s] = *(const bf16x8s*)(qbase + qt * 64 + 16 * s + 8 * hh);
    f32x16 o0, o1;
    float m_run = -40.0f, l_run = 0.f;
    if (MODE == 2) { const float* xr = X + (size_t)pol.xrow(r) * 68;
#pragma unroll
        for (int g = 0; g < 4; ++g) { const float4 a0 = *(const float4*)(xr + 8 * g + 4 * hh), a1 = *(const float4*)(xr + 32 + 8 * g + 4 * hh);
            o0[4 * g] = a0.x; o0[4 * g + 1] = a0.y; o0[4 * g + 2] = a0.z; o0[4 * g + 3] = a0.w; o1[4 * g] = a1.x; o1[4 * g + 1] = a1.y; o1[4 * g + 2] = a1.z; o1[4 * g + 3] = a1.w; }
        m_run = xr[64]; l_run = hh == 0 ? xr[65] : 0.f;
    } else {
#pragma unroll
        for (int i = 0; i < 16; ++i) { o0[i] = 0.f; o1[i] = 0.f; } }
    constexpr int NB = Pol::NB;
    bf16x8s kf[4]; u32x4a vfA[4];
    attn_loadk<Pol>(kbase, pol, 0, r, hh, kf);
    attn_loadv<Pol>(vbase, pol, 0, r, hh, vfA);
#pragma unroll 1
    for (int fb = 0; fb < NB; ++fb)
        attn_compute<Pol>(kbase, pol, fb, fb + 1 < NB ? fb + 1 : NB - 1, (MODE != 2) && (fb == 0), r, hh, xaddr, qf, kf, vfA, vbase, wl, o0, o1, m_run, l_run);
    l_run += bperm_f(xaddr, l_run);
    if (MODE == 1) { float* xr = X + (size_t)pol.xrow(r) * 68;
#pragma unroll
        for (int g = 0; g < 4; ++g) { *(float4*)(xr + 8 * g + 4 * hh) = make_float4(o0[4 * g], o0[4 * g + 1], o0[4 * g + 2], o0[4 * g + 3]);
            *(float4*)(xr + 32 + 8 * g + 4 * hh) = make_float4(o1[4 * g], o1[4 * g + 1], o1[4 * g + 2], o1[4 * g + 3]); }
        if (hh == 0) { xr[64] = m_run; xr[65] = l_run; }
        return; }
    attn_store_out(o0, o1, 1.0f / l_run, gbase, qt, yout, b, h, hh);
}
#define SC2 (0.125f * 1.44269504088896341f)
#define CI32(i) (((i) & 3) + 8 * ((i) >> 2))
struct DilPolA { static constexpr int NB = 13; int t0, xq0; const LAS float* tbl16; const LAS float* tbl4;
    __device__ __forceinline__ void init(int, int) {}
    __device__ __forceinline__ int qtok(int n) const { return t0 + 16 * n; }
    __device__ __forceinline__ int xrow(int n) const { return xq0 + 16 * n; }
    __device__ __forceinline__ int stride(int fb) const { return fb < 5 ? 16 : 4; }
    __device__ __forceinline__ int kbof(int fb) const { return fb < 5 ? fb : fb - 5; }
    __device__ __forceinline__ int ktok(int fb, int ks) const { int t = t0 + stride(fb) * (-64 + 32 * kbof(fb) + ks); t = t < 0 ? 0 : (t > SEQ - 1 ? SEQ - 1 : t); return t; }
    __device__ __forceinline__ void scores(int fb, int n, int hh, f32x16& sc) const {
        const int st = stride(fb), kb = kbof(fb);
        const int brel = st * (-64 + 32 * kb + 4 * hh) - 16 * n, bidx = brel + 1536, tkb = t0 + st * (-64 + 32 * kb + 4 * hh);
        const int tlo = t0 + st * (-64 + 32 * kb); const bool edge = (tlo < 0) || (tlo + 31 * st > SEQ - 1);
        if (fb < 5) { const LAS float* tp = tbl16 + bidx + (bidx >> 4);
#pragma unroll
            for (int i = 0; i < 16; ++i) { float v = sc[i] * SC2 + tp[17 * CI32(i)]; if (edge) v = ((unsigned)(tkb + 16 * CI32(i)) < (unsigned)SEQ) ? v : -1e30f; sc[i] = v; }
        } else { const LAS float* tp = tbl4 + bidx + (bidx >> 4);
#pragma unroll
            for (int i = 0; i < 16; ++i) { float v = sc[i] * SC2 + tp[4 * CI32(i) + (CI32(i) >> 2)]; if (edge) v = ((unsigned)(tkb + 4 * CI32(i)) < (unsigned)SEQ) ? v : -1e30f; sc[i] = v; } }
        } };
struct DilPolB { static constexpr int NB = 5; int q0, xq0; const LAS float* tblB;
    __device__ __forceinline__ void init(int, int) {}
    __device__ __forceinline__ int qtok(int n) const { return q0 + n; }
    __device__ __forceinline__ int xrow(int n) const { return xq0 + n; }
    __device__ __forceinline__ int ktok(int fb, int ks) const { int t = q0 - 64 + 32 * fb + ks; t = t < 0 ? 0 : (t > SEQ - 1 ? SEQ - 1 : t); return t; }
    __device__ __forceinline__ void scores(int fb, int n, int hh, f32x16& sc) const {
        const int tlo = q0 - 64 + 32 * fb; const bool edge = (tlo < 0) || (tlo + 31 > SEQ - 1);
        const LAS float* tp = tblB + (-64 + 32 * fb + 4 * hh - n + 96); const int tkb = tlo + 4 * hh;
#pragma unroll
        for (int i = 0; i < 16; ++i) { float v = sc[i] * SC2 + tp[CI32(i)]; if (edge) v = ((unsigned)(tkb + CI32(i)) < (unsigned)SEQ) ? v : -1e30f; sc[i] = v; }
        } };
struct NatPol { static constexpr int NB = 9; int r0, c0, rs0, cw0; const LAS float* rpbh; int colmask, cbase, rq, rsq;
    __device__ __forceinline__ int xrow(int) const { return 0; }
    __device__ __forceinline__ void init(int n, int hh) { rq = r0 + (n >> 4); const int cq = c0 + (n & 15); rsq = rq - 4; rsq = rsq < 0 ? 0 : (rsq > 56 ? 56 : rsq); int csq = cq - 8; csq = csq < 0 ? 0 : (csq > 48 ? 48 : csq);
        cbase = cw0 + 4 * hh - cq + 15; int m = 0;
#pragma unroll
        for (int i = 0; i < 16; ++i) { const int ck = cw0 + 4 * hh + CI32(i); m |= (ck >= csq && ck < csq + 16) ? (1 << i) : 0; }
        colmask = m; }
    __device__ __forceinline__ int qtok(int n) const { return (r0 + (n >> 4)) * 64 + c0 + (n & 15); }
    __device__ __forceinline__ int ktok(int kb, int ks) const { int rk = rs0 + kb; rk = rk > 63 ? 63 : rk; return rk * 64 + cw0 + ks; }
    __device__ __forceinline__ void scores(int kb, int, int, f32x16& sc) const {
        const int rk = rs0 + kb; const bool rowok = rk >= rsq && rk < rsq + 8 && rk < 64; const int em = rowok ? colmask : 0;
        int ro = rk - rq + 7; ro = ro < 0 ? 0 : (ro > 14 ? 14 : ro); const LAS float* tp = rpbh + ro * 31 + cbase;
        float bv[16];
#pragma unroll
        for (int i = 0; i < 16; ++i) bv[i] = tp[CI32(i)];
#pragma unroll
        for (int i = 0; i < 16; ++i) { const float v = sc[i] * SC2 + bv[i]; sc[i] = (em & (1 << i)) ? v : -1e30f; }
        } };
__device__ __forceinline__ void natten_wave_task2(const bf16_t* __restrict__ proj, int b, int h, NatPol pA, NatPol pB, bf16_t* __restrict__ yout, int lane, LAS unsigned char* wl) {
    const int r = lane & 31, hh = lane >> 5, xaddr = (lane ^ 32) << 2;
    pA.init(r, hh); pB.init(r, hh);
    const int qtA = pA.qtok(r), qtB = pB.qtok(r);
    const bf16_t* qbase = proj + (size_t)(b * 16 + h) * (4096 * 64); const bf16_t* kbase = qbase + (size_t)T_TOK * 1024; const bf16_t* vbase = kbase + (size_t)T_TOK * 1024; const bf16_t* gbase = vbase + (size_t)T_TOK * 1024;
    bf16x8s qA[4], qB[4];
#pragma unroll
    for (int s = 0; s < 4; ++s) { qA[s] = *(const bf16x8s*)(qbase + qtA * 64 + 16 * s + 8 * hh); qB[s] = *(const bf16x8s*)(qbase + qtB * 64 + 16 * s + 8 * hh); }
    f32x16 oA0, oA1, oB0, oB1;
#pragma unroll
    for (int i = 0; i < 16; ++i) { oA0[i] = 0.f; oA1[i] = 0.f; oB0[i] = 0.f; oB1[i] = 0.f; }
    float mA = -40.0f, lA = 0.f, mB = -40.0f, lB = 0.f;
    constexpr int NB = 11;
    bf16x8s kf[4]; u32x4a vg[4];
    attn_loadk<NatPol>(kbase, pA, 0, r, hh, kf);
    attn_loadv<NatPol>(vbase, pA, 0, r, hh, vg);
#pragma unroll 1
    for (int fb = 0; fb < NB; ++fb) {
        const int fbn = fb + 1 < NB ? fb + 1 : NB - 1;
        f32x16 scA, scB;
#pragma unroll
        for (int i = 0; i < 16; ++i) { scA[i] = 0.f; scB[i] = 0.f; }
#pragma unroll
        for (int s = 0; s < 4; ++s) { scA = __builtin_amdgcn_mfma_f32_32x32x16_bf16(kf[s], qA[s], scA, 0, 0, 0); scB = __builtin_amdgcn_mfma_f32_32x32x16_bf16(kf[s], qB[s], scB, 0, 0, 0); }
        attn_loadk<NatPol>(kbase, pA, fbn, r, hh, kf);
        pA.scores(fb, r, hh, scA); pB.scores(fb, r, hh, scB);
        if (fb == 0) { float ba = scA[0], bb = scB[0];
#pragma unroll
            for (int i = 1; i < 16; ++i) { ba = fmaxf(ba, scA[i]); bb = fmaxf(bb, scB[i]); }
            ba = fmaxf(ba, bperm_f(xaddr, ba)); bb = fmaxf(bb, bperm_f(xaddr, bb)); mA = fmaxf(ba, -40.0f); mB = fmaxf(bb, -40.0f); }
        float psA = 0.f, psB = 0.f;
#pragma unroll
        for (int i = 0; i < 16; ++i) { const float pa = __builtin_amdgcn_exp2f(scA[i] - mA); scA[i] = pa; psA += pa; const float pb = __builtin_amdgcn_exp2f(scB[i] - mB); scB[i] = pb; psB += pb; }
        lA += psA; lB += psB;
        { asm volatile("" ::: "memory");
#pragma unroll
          for (int j = 0; j < 4; ++j) *(LAS u32x4a*)(wl + (8 * j + (lane >> 3)) * 144 + (lane & 7) * 16) = vg[j];
          asm volatile("" ::: "memory"); }
        attn_loadv<NatPol>(vbase, pA, fbn, r, hh, vg);
        u32x4a va[2], vb[2];
        { const LAS unsigned short* rp = (const LAS unsigned short*)(wl + (4 * hh) * 144 + r * 2);
#pragma unroll
          for (int s = 0; s < 2; ++s)
#pragma unroll
            for (int jx = 0; jx < 4; ++jx) { const int k0 = 16 * s + 8 * ((2 * jx) >> 2) + ((2 * jx) & 3), k1 = k0 + 1;
                va[s][jx] = (unsigned)rp[k0 * 72] | ((unsigned)rp[k1 * 72] << 16); vb[s][jx] = (unsigned)rp[k0 * 72 + 32] | ((unsigned)rp[k1 * 72 + 32] << 16); } }
#pragma unroll
        for (int s = 0; s < 2; ++s) { f32x8v ta, tb;
#pragma unroll
            for (int jx = 0; jx < 8; ++jx) { ta[jx] = scA[8 * s + jx]; tb[jx] = scB[8 * s + jx]; }
            const bf16x8s pfa = __builtin_bit_cast(bf16x8s, __builtin_convertvector(ta, bf16x8n)), pfb = __builtin_bit_cast(bf16x8s, __builtin_convertvector(tb, bf16x8n));
            oA0 = __builtin_amdgcn_mfma_f32_32x32x16_bf16(__builtin_bit_cast(bf16x8s, va[s]), pfa, oA0, 0, 0, 0);
            oA1 = __builtin_amdgcn_mfma_f32_32x32x16_bf16(__builtin_bit_cast(bf16x8s, vb[s]), pfa, oA1, 0, 0, 0);
            oB0 = __builtin_amdgcn_mfma_f32_32x32x16_bf16(__builtin_bit_cast(bf16x8s, va[s]), pfb, oB0, 0, 0, 0);
            oB1 = __builtin_amdgcn_mfma_f32_32x32x16_bf16(__builtin_bit_cast(bf16x8s, vb[s]), pfb, oB1, 0, 0, 0); }
    }
    lA += bperm_f(xaddr, lA); lB += bperm_f(xaddr, lB);
    attn_store_out(oA0, oA1, 1.0f / lA, gbase, qtA, yout, b, h, hh);
    attn_store_out(oB0, oB1, 1.0f / lB, gbase, qtB, yout, b, h, hh);
}
__device__ void ph_dilated_mfma(const Params& P, const bf16_t* __restrict__ proj, bf16_t* __restrict__ yout, unsigned char* lds_raw, float* __restrict__ Xall) {
    const int tid = otid(); const int lane = tid & 63, wid = tid >> 6;
    LAS float* tbl = (LAS float*)lds_raw; LAS unsigned char* wl = (LAS unsigned char*)lds_raw + 32768 + wid * 4608;
    const float* rel_bias = P.in[17];
    const int G = gridDim.x, bid = blockIdx.x, vb = (G % 8 == 0) ? (bid & 7) * (G >> 3) + (bid >> 3) : bid;
    float* X = Xall + (size_t)bid * 512 * 68;
#pragma unroll 1
    for (int bt = vb; bt < 1024; bt += G) {
        const int p = bt >> 3, chunk = bt & 7, b = p >> 4, h = p & 15;
        __syncthreads();
        LAS float* tbl16 = tbl; LAS float* tbl4 = tbl + 3328; LAS float* tblB = tbl + 6656;
        for (int x = tid; x < 3073; x += NT) { const int rel = x - 1536, ar = rel < 0 ? -rel : rel; const float bv = rel_bias[t5_bucket(rel) * 16 + h] * 1.44269504088896341f;
            tbl16[x + (x >> 4)] = ((rel & 15) == 0 && ar <= 1024) ? bv : -1e30f; tbl4[x + (x >> 4)] = ((rel & 3) == 0 && ar <= 256) ? bv : -1e30f; }
        for (int x = tid; x < 256; x += NT) { const int rel = x - 96, ar = rel < 0 ? -rel : rel; tblB[x] = (ar <= 64) ? rel_bias[t5_bucket(rel) * 16 + h] * 1.44269504088896341f : -1e30f; }
        __syncthreads();
#pragma unroll 1
        for (int rr = 0; rr < 2; ++rr) { const int res = wid * 2 + rr; DilPolA pol{chunk * 512 + res, res, tbl16, tbl4}; attn_wave_task<DilPolA, 1>(proj, b, h, pol, yout, lane, X, wl); }
        __syncthreads();
#pragma unroll 1
        for (int rr = 0; rr < 2; ++rr) { const int qs = (wid * 2 + rr) * 32; DilPolB pol{chunk * 512 + qs, qs, tblB}; attn_wave_task<DilPolB, 2>(proj, b, h, pol, yout, lane, X, wl); }
    }
}
__device__ void ph_natten_mfma(const Params& P, int j, int half, const bf16_t* __restrict__ proj, bf16_t* __restrict__ yout, unsigned char* lds_raw) {
    const int tid = otid(); const int lane = tid & 63, wid = tid >> 6;
    LAS float* tbl = (LAS float*)lds_raw; LAS unsigned char* wl = (LAS unsigned char*)lds_raw + 32768 + wid * 4608;
    const float* rpb = P.in[18] + (size_t)j * 32 * 15 * 31;
    const int G = gridDim.x, bid = blockIdx.x, vb = (G % 8 == 0) ? (bid & 7) * (G >> 3) + (bid >> 3) : bid;
#pragma unroll 1
    for (int id0 = vb * 8; id0 < 8192; id0 += G * 8) {
        const int p = id0 >> 6, b = p >> 4, h = p & 15, wt = (id0 & 63) + wid;
        __syncthreads();
        for (int x = tid; x < 465; x += NT) tbl[64 + x] = rpb[(size_t)(half * 16 + h) * 465 + x] * 1.44269504088896341f;
        __syncthreads();
        const int r0 = (wt >> 2) * 4, c0 = (wt & 3) * 16;
        int rs0 = r0 - 4; rs0 = rs0 < 0 ? 0 : (rs0 > 56 ? 56 : rs0); int cw0 = c0 - 8; cw0 = cw0 < 0 ? 0 : (cw0 > 32 ? 32 : cw0);
        NatPol polA{r0, c0, rs0, cw0, tbl + 64, 0, 0, 0, 0}, polB{r0 + 2, c0, rs0, cw0, tbl + 64, 0, 0, 0, 0};
        natten_wave_task2(proj, b, h, polA, polB, yout, lane, wl);
    }
}

__device__ __forceinline__ void unpack8(const uint4& w, float (&f)[8]) {
    f[0] = __uint_as_float(w.x << 16); f[1] = __uint_as_float(w.x & 0xffff0000u); f[2] = __uint_as_float(w.y << 16); f[3] = __uint_as_float(w.y & 0xffff0000u);
    f[4] = __uint_as_float(w.z << 16); f[5] = __uint_as_float(w.z & 0xffff0000u); f[6] = __uint_as_float(w.w << 16); f[7] = __uint_as_float(w.w & 0xffff0000u); }
__device__ void ph_post(const float* hin_f, const bf16_t* hin_b, const bf16_t* t1, const float* gpost, bf16_t* E, const float* gple, bf16_t* h1b) {
    const int tid = otid(); const int lane = tid & 63, wid = tid >> 6;
    for (int row = blockIdx.x * 8 + wid; row < T_TOK; row += gridDim.x * 8) {
        const size_t ro = (size_t)row * DM;
        uint4 tw[2], ew[2]; float hv[2][8];
#pragma unroll
        for (int i = 0; i < 2; ++i) { const int e0 = (lane + 64 * i) * 8; tw[i] = ntld_u4(t1 + ro + e0); ew[i] = ntld_u4(E + ro + e0); }
        if (hin_b) {
#pragma unroll
            for (int i = 0; i < 2; ++i) { const uint4 hw = ntld_u4(hin_b + ro + (lane + 64 * i) * 8); unpack8(hw, hv[i]); }
        } else {
#pragma unroll
            for (int i = 0; i < 2; ++i) { const int e0 = (lane + 64 * i) * 8; const float4 a = ntld_f4(hin_f + ro + e0), b = ntld_f4(hin_f + ro + e0 + 4);
                hv[i][0] = a.x; hv[i][1] = a.y; hv[i][2] = a.z; hv[i][3] = a.w; hv[i][4] = b.x; hv[i][5] = b.y; hv[i][6] = b.z; hv[i][7] = b.w; } }
        float tv[2][8], ev[2][8]; float ss = 0.f, se = 0.f;
#pragma unroll
        for (int i = 0; i < 2; ++i) { unpack8(tw[i], tv[i]); unpack8(ew[i], ev[i]);
#pragma unroll
            for (int k = 0; k < 8; ++k) { ss += tv[i][k] * tv[i][k]; se += ev[i][k] * ev[i][k]; } }
        ss = wave_sum(ss); se = wave_sum(se);
        const float r = rsqrtf(ss * (1.0f / DM) + RMS_EPS), re = rsqrtf(se * (1.0f / DM) + RMS_EPS);
        float4 gaa[2], gbb[2], paa[2], pbb[2];
#pragma unroll
        for (int i = 0; i < 2; ++i) { const int e0 = (lane + 64 * i) * 8; gaa[i] = *(const float4*)(gpost + e0); gbb[i] = *(const float4*)(gpost + e0 + 4); paa[i] = *(const float4*)(gple + e0); pbb[i] = *(const float4*)(gple + e0 + 4); }
#pragma unroll
        for (int i = 0; i < 2; ++i) { const int e0 = (lane + 64 * i) * 8;
            const float4 ga = gaa[i], gb = gbb[i], pa = paa[i], pb = pbb[i];
            const float gg[8] = {ga.x, ga.y, ga.z, ga.w, gb.x, gb.y, gb.z, gb.w}, pp[8] = {pa.x, pa.y, pa.z, pa.w, pb.x, pb.y, pb.z, pb.w};
            float o[8], x[8];
#pragma unroll
            for (int k = 0; k < 8; ++k) { o[k] = hv[i][k] + tv[i][k] * r * gg[k]; x[k] = ev[i][k] * re * pp[k]; }
            uint4 w; w.x = pg8::cvt_pk_bf16(o[0], o[1]); w.y = pg8::cvt_pk_bf16(o[2], o[3]); w.z = pg8::cvt_pk_bf16(o[4], o[5]); w.w = pg8::cvt_pk_bf16(o[6], o[7]);
            *(uint4*)(h1b + ro + e0) = w;
            uint4 xx; xx.x = pg8::cvt_pk_bf16(x[0], x[1]); xx.y = pg8::cvt_pk_bf16(x[2], x[3]); xx.z = pg8::cvt_pk_bf16(x[4], x[5]); xx.w = pg8::cvt_pk_bf16(x[6], x[7]);
            *(uint4*)(E + ro + e0) = xx; }
    }
}

#define XB_TMO      128
#define XB_XCNT(j)  (256  + 64 * (j))
#define XB_XSUB(j)  (1280 + 64 * (j))
#define XB_XGEN(j)  (2304 + 64 * (j))
#define XB_TOP      3328
#define XB_TOPGEN   3392
#define XCD_BAR_WORDS 3456
#define XB_SPIN_CAP (1u << 18)
__device__ __forceinline__ unsigned xb_ld(unsigned* p)              { return __hip_atomic_load(p, __ATOMIC_RELAXED, __HIP_MEMORY_SCOPE_AGENT); }
__device__ __forceinline__ unsigned xb_add(unsigned* p, unsigned v) { return __hip_atomic_fetch_add(p, v, __ATOMIC_RELAXED, __HIP_MEMORY_SCOPE_AGENT); }
__device__ __forceinline__ unsigned xb_xcc_id() { return (unsigned)__builtin_amdgcn_s_getreg((3 << 11) | 20) & 0xFu; }
#define XB_SPIN(cond, bar) do { unsigned _sp = 0; while (cond) { __builtin_amdgcn_s_sleep(1); \
    if ((++_sp & 255u) == 0u) { if (xb_ld(&(bar)[XB_TMO])) break; if (_sp > XB_SPIN_CAP) { atomicAdd(&(bar)[XB_TMO], 1u); break; } } } } while (0)
struct XcdBarrier { unsigned* bar; unsigned x; volatile LAS unsigned* st; };
__device__ __forceinline__ XcdBarrier xcd_barrier_post(unsigned* bar, volatile LAS unsigned* st) {
    XcdBarrier b; b.bar = bar; b.x = xb_xcc_id(); b.st = st;
    if (threadIdx.x == 0) (void)xb_add(&bar[XB_XCNT(b.x)], 1u);
    return b;
}
__device__ __forceinline__ void xcd_barrier_complete(unsigned* bar, unsigned x, unsigned& nloc, unsigned& nx) {
    const unsigned G = gridDim.x * gridDim.y * gridDim.z;
    unsigned sum, cnt, mine, sp = 0u;
    for (;;) {
        sum = 0u; cnt = 0u; mine = 0u;
#pragma unroll
        for (unsigned j = 0; j < 16; ++j) { const unsigned c = xb_ld(&bar[XB_XCNT(j)]); sum += c; cnt += (c > 0u) ? 1u : 0u; mine = (j == x) ? c : mine; }
        if (sum == G) break;
        __builtin_amdgcn_s_sleep(1);
        if ((++sp & 255u) == 0u) { if (xb_ld(&bar[XB_TMO])) break; if (sp > XB_SPIN_CAP) { atomicAdd(&bar[XB_TMO], 1u); break; } }
    }
    nloc = mine > 0u ? mine : 1u; nx = cnt > 0u ? cnt : 1u;
}
__device__ __forceinline__ void xcd_barrier(const XcdBarrier& b) {
    asm volatile("s_waitcnt vmcnt(0)" ::: "memory");
    __syncthreads();
    if (threadIdx.x == 0) {
        unsigned* bar = b.bar;
        __builtin_amdgcn_s_waitcnt(0);
        unsigned nloc = b.st[0], nx = b.st[1];
        if (nloc == 0u) { xcd_barrier_complete(bar, b.x, nloc, nx); b.st[0] = nloc; b.st[1] = nx; }
        const unsigned old = xb_add(&bar[XB_XSUB(b.x)], 1u);
        const unsigned gen = old / nloc;
        if (old + 1u == (gen + 1u) * nloc) {
            __builtin_amdgcn_fence(__ATOMIC_RELEASE, "agent");
            asm volatile("s_waitcnt vmcnt(0)" ::: "memory");
            const unsigned og = xb_add(&bar[XB_TOP], 1u);
            const unsigned tg = og / nx;
            if (og + 1u == (tg + 1u) * nx) xb_add(&bar[XB_TOPGEN], 1u);
            else XB_SPIN(xb_ld(&bar[XB_TOPGEN]) == tg, bar);
            __builtin_amdgcn_fence(__ATOMIC_ACQUIRE, "agent");
            xb_add(&bar[XB_XGEN(b.x)], 1u);
            asm volatile("s_waitcnt vmcnt(0)" ::: "memory");
        } else {
            XB_SPIN(xb_ld(&bar[XB_XGEN(b.x)]) == gen, bar);
            __builtin_amdgcn_fence(__ATOMIC_ACQUIRE, "agent");
            asm volatile("s_waitcnt vmcnt(0)" ::: "memory");
        }
    }
    __syncthreads();
}
__device__ __forceinline__ void grid_bar(unsigned* ctr, unsigned& epoch, unsigned G) {
    __syncthreads();
    if (threadIdx.x == 0) {
        epoch += 1u;
        __threadfence();
        __hip_atomic_fetch_add(ctr, 1u, __ATOMIC_RELAXED, __HIP_MEMORY_SCOPE_AGENT);
        const unsigned target = epoch * G;
        while (__hip_atomic_load(ctr, __ATOMIC_RELAXED, __HIP_MEMORY_SCOPE_AGENT) < target) __builtin_amdgcn_s_sleep(1);
        __threadfence();
    }
    __syncthreads();
}
__global__ void __launch_bounds__(NT) fwd_megakernel(Params P) {
    extern __shared__ __attribute__((aligned(16))) unsigned char lds_raw[];
    cg::grid_group grid = cg::this_grid();
    PG8_LAS unsigned char* lds = (PG8_LAS unsigned char*)lds_raw;
    float* sl = (float*)lds_raw;
    unsigned char* ws = P.ws;
    const int G = gridDim.x, bid = blockIdx.x;
    bf16_t* U = (bf16_t*)(ws + WS_U); bf16_t* PROJ = (bf16_t*)(ws + WS_PROJ); bf16_t* T1 = (bf16_t*)(ws + WS_T1); bf16_t* E = (bf16_t*)(ws + WS_E);
    bf16_t* YA = (bf16_t*)(ws + WS_YA); bf16_t* YB = (bf16_t*)(ws + WS_YB); float* KF = (float*)(ws + WS_YA);
    bf16_t* WIN = (bf16_t*)(ws + WS_WIN); bf16_t* WOUT = (bf16_t*)(ws + WS_WOUT); bf16_t* PPROJ = (bf16_t*)(ws + WS_PPROJ); bf16_t* PGATE = (bf16_t*)(ws + WS_PGATE);
    bf16_t* PB = (bf16_t*)(ws + WS_PB); float* A3 = (float*)(ws + WS_A3);
    int ph = 0;
    volatile LAS unsigned* xst = (volatile LAS unsigned*)((LAS unsigned char*)lds_raw + 144 * 1024);
    if (threadIdx.x < 4) xst[threadIdx.x] = 0u;
    __syncthreads();
    const XcdBarrier xbar = xcd_barrier_post((unsigned*)(ws + WS_CTL), xst);
#define PHASE_BEGIN if (ph >= P.ph_lo && ph < P.ph_hi) {
#define PHASE_END   if (ph + 1 < P.ph_hi) { if (P.ph_hi < 0) grid.sync(); else xcd_barrier(xbar); } } ++ph;
#pragma unroll 1
    for (int layer = 0; layer < 4; ++layer) {
        const bool even = !(layer & 1); const int j = layer >> 1;
        bf16_t* HBUF = (bf16_t*)P.out;
        PHASE_BEGIN
#pragma unroll 1
            for (int rep = 0; rep < ((REP_MASK & 8) ? 2 : 1); ++rep) {
            if (layer == 0) ph_rmsnorm_rows(P.in[0], P.in[4] + layer * DM, U); else ph_rmsnorm_rows_b16(HBUF, P.in[4] + layer * DM, U);
            ph_prep_weights(P, layer, sl);
            ph_convert_p(P.in[1] + (size_t)layer * T_TOK * PLE, PB);
            if (even) ph_filter_mlp(P, j, A3);
            }
            if (REP_MASK & 16) { for (int rep = 0; rep < 8; ++rep) grid.sync(); }
        PHASE_END
        PHASE_BEGIN
            pg8::StaticOrder S; pg8::Gemm g; pg8::EpiBf16 Ep;
            if (even) { g = pg8::Gemm{WIN, U, 4096, T_TOK, 1024, 1024, 1 << 20, 0ll}; Ep = pg8::EpiBf16{PROJ, (size_t)T_TOK, 0}; S.init(4096, T_TOK, G, bid); }
            else      { g = pg8::Gemm{U, WIN, T_TOK, 4096, 1024, 1024, 1 << 20, 0ll}; Ep = pg8::EpiBf16{PROJ, (size_t)4096, 1}; S.init(T_TOK, 4096, G, bid); }
#pragma unroll 1
            for (int rep = 0; rep < ((REP_MASK & 1) ? 2 : 1); ++rep)
            pg8::gemm_phase<pg8::EpiBf16, pg8::StaticOrder>(lds, g, S, Ep);
#pragma unroll 1
            for (int rep = 0; rep < ((REP_MASK & 32) ? 2 : 1); ++rep)
            if (even) { __syncthreads(); ph_filter_gen(P, j, A3, KF, sl); }
        PHASE_END
        PHASE_BEGIN
            #if HY_FFT
#pragma unroll 1
            for (int rep = 0; rep < ((REP_MASK & 2) ? 2 : 1); ++rep)
            if (even) ph_hyena_fft(P, j, PROJ, KF, YB, lds_raw);
#else
            if (even) ph_hyena_naive(P, j, PROJ, KF, YB, sl);
#endif
#if ATT_MFMA
#pragma unroll 1
            for (int rep = 0; rep < (((REP_MASK & 4) || ((REP_MASK & 64) && !even)) ? 2 : 1); ++rep)
            if (!even) ph_natten_mfma(P, j, 0, PROJ, YA, lds_raw);
#else
            else ph_natten_naive(P, j, 0, PROJ, YA);
#endif
        PHASE_END
        PHASE_BEGIN
            pg8::StaticOrder S; S.init(T_TOK, 4096, G, bid);
            pg8::Gemm g{U, WIN + (size_t)4096 * 1024, T_TOK, 4096, 1024, 1024, 1 << 20, 0ll}; pg8::EpiBf16 Ep{PROJ, (size_t)4096, 1};
#pragma unroll 1
            for (int rep = 0; rep < ((REP_MASK & 1) ? 2 : 1); ++rep)
            pg8::gemm_phase<pg8::EpiBf16, pg8::StaticOrder>(lds, g, S, Ep);
#pragma unroll 1
            for (int rep = 0; rep < ((REP_MASK & 32) ? 2 : 1); ++rep)
            if (even) { __syncthreads(); ph_transpose_ya(YB, YA, (bf16_t*)lds_raw); }
        PHASE_END
        PHASE_BEGIN
#if ATT_MFMA
#pragma unroll 1
            for (int rep = 0; rep < (((REP_MASK & 4) || ((REP_MASK & 64) && !even) || ((REP_MASK & 128) && even)) ? 2 : 1); ++rep) {
            if (even) ph_dilated_mfma(P, PROJ, YB, lds_raw, (float*)(ws + WS_U));
            else ph_natten_mfma(P, j, 1, PROJ, YB, lds_raw);
            }
#else
            if (even) ph_dilated_naive(P, PROJ, YB);
            else ph_natten_naive(P, j, 1, PROJ, YB);
#endif
        PHASE_END
        PHASE_BEGIN
#pragma unroll 1
            for (int qq = 0; qq < ((REP_MASK & 1) ? 4 : 2); ++qq) { const int q = qq & 1;
                pg8::StaticOrder S; S.init(T_TOK, 1024, G, bid);
                pg8::Gemm g = q == 0 ? pg8::Gemm{YA, WOUT, T_TOK, 1024, 2048, 1024, 16, (long long)(WS_YB - WS_YA) - 16ll * 128}
                                     : pg8::Gemm{PB, PPROJ, T_TOK, 1024, 256, 256, 1 << 20, 0ll};
                pg8::EpiBf16 Ep{q == 0 ? T1 : E, (size_t)1024, 0};
                pg8::gemm_phase<pg8::EpiBf16, pg8::StaticOrder>(lds, g, S, Ep);
            }
        PHASE_END
        PHASE_BEGIN
            ph_post(P.in[0], layer == 0 ? (const bf16_t*)nullptr : (const bf16_t*)HBUF, T1, P.in[5] + layer * DM, E, P.in[20] + layer * DM, U);
        PHASE_END
        PHASE_BEGIN
            pg8::StaticOrder S; S.init(T_TOK, 1024, G, bid);
            pg8::Gemm g{U, PGATE, T_TOK, 1024, 1024, 1024, 1 << 20, 0ll}; pg8::EpiGate Ep{U, E, HBUF, layer == 3 ? P.out : (float*)nullptr, 1024};
            pg8::gemm_phase<pg8::EpiGate, pg8::StaticOrder>(lds, g, S, Ep);
        PHASE_END
    }
}

extern "C" void kernel_launch(void* const* d_in, const int* in_sizes, int n_in, void* d_out, int out_size, void* d_ws, size_t ws_size, hipStream_t stream) {
    static int grid_blocks = 0;
    if (grid_blocks == 0) {
        if (n_in != 22 || ws_size < WS_END) { fprintf(stderr, "kernel_launch: unexpected n_in %d / ws_size %zu\n", n_in, ws_size); grid_blocks = -1; return; }
        int dev = 0, cus = 0, per_cu = 0;
        hipGetDevice(&dev); hipDeviceGetAttribute(&cus, hipDeviceAttributeMultiprocessorCount, dev);
        if (hipFuncSetAttribute((const void*)fwd_megakernel, hipFuncAttributeMaxDynamicSharedMemorySize, LDS_BYTES) != hipSuccess) { fprintf(stderr, "hipFuncSetAttribute failed\n"); grid_blocks = -1; return; }
        if (hipOccupancyMaxActiveBlocksPerMultiprocessor(&per_cu, (const void*)fwd_megakernel, NT, LDS_BYTES) != hipSuccess || per_cu < 1) { fprintf(stderr, "occupancy query: %d\n", per_cu); per_cu = 1; }
        (void)hipGetLastError();
        grid_blocks = cus;
    }
    if (grid_blocks < 0) return;
    if (hipMemsetAsync((char*)d_ws + WS_CTL, 0, XCD_BAR_WORDS * 4, stream) != hipSuccess) { fprintf(stderr, "memset failed\n"); return; }
    Params p{};
    for (int i = 0; i < 22; ++i) p.in[i] = (const float*)d_in[i];
    p.out = (float*)d_out; p.ws = (unsigned char*)d_ws; p.ph_lo = 0; p.ph_hi = 32;
    void* args[] = {&p};
    hipError_t e = hipLaunchCooperativeKernel((const void*)fwd_megakernel, dim3(grid_blocks), dim3(NT), args, LDS_BYTES, stream);
    if (e != hipSuccess) fprintf(stderr, "cooperative launch failed: %s (grid %d)\n", hipGetErrorString(e), grid_blocks);
}
```
